# Optimizing an MI355X kernel written in HIP

```python
import jax, jax.numpy as jnp
from jax import lax
import numpy as np

D_MODEL = 1024
BATCH = 1
SEQ = 16384
DEPTH = 4

N_A = DEPTH // 2
N_B = DEPTH - N_A
N_DENSE = (DEPTH + 1) // 2
N_MOE = DEPTH // 2
EPS = 1e-6
CHUNK = 128
A_WIDTH = 2 * D_MODEL
A_GROUPS = 8
N_HEADS = 16
N_KV = 4
HPG = N_HEADS // N_KV
HEAD_DIM = D_MODEL // N_HEADS
L_CMP = 32
D_CMP = 16
L_SEL = 64
N_SELECT = 16
WINDOW = 512
Q_BLK = 128
CMP_HIDDEN = 4 * HEAD_DIM
D_FF = 2816
N_EXPERTS = 8
TOP_K = 2
D_EXPERT = 7 * D_MODEL // 2
MOE_BLOCK = 256
NEG = -1e30
FORCE_BONUS = 1e4

kernel_name = 'hybrid_gmlp_nsa_yoco_block'


def rms_norm(x, g):
    x32 = x.astype(jnp.float32)
    y = x32 * lax.rsqrt(jnp.mean(x32 * x32, axis=-1, keepdims=True) + EPS)
    return y.astype(x.dtype) * g


def layer_norm(x, g, b):
    x32 = x.astype(jnp.float32)
    mu = jnp.mean(x32, axis=-1, keepdims=True)
    var = jnp.mean(jnp.square(x32 - mu), axis=-1, keepdims=True)
    return ((x32 - mu) * lax.rsqrt(var + EPS)).astype(x.dtype) * g + b


def ada_mod(c_act, w, b, n):
    m = (c_act @ w + b)[:, None, :]
    return jnp.split(m, n, axis=-1)


def gmlp_mix(h, w_in, ln_g, ln_b, ws, bs, w_out):
    B_, S_, _ = h.shape
    z = jax.nn.gelu(h @ w_in)
    u, v = jnp.split(z, 2, axis=-1)
    v = layer_norm(v, ln_g, ln_b)
    causal = jnp.tril(jnp.ones((CHUNK, CHUNK), dtype=bool))
    wsm = jnp.where(causal[None], ws, jnp.zeros_like(ws))
    vc = v.reshape(B_, S_ // CHUNK, CHUNK, A_GROUPS, A_WIDTH // A_GROUPS)
    mixed = jnp.einsum('gts,bcsgd->bctgd', wsm, vc) + bs.T[None, None, :, :, None]
    return (u * mixed.reshape(B_, S_, A_WIDTH)) @ w_out


def nsa_shared_kv(x, c_act, kv_norm_g, kv_ada_w, kv_ada_b, w_kv, cmp_pos, cmp_w1, cmp_b1, cmp_w2, cmp_b2):
    B_, S_, _ = x.shape
    shift, scale = ada_mod(c_act, kv_ada_w, kv_ada_b, 2)
    h = rms_norm(x, kv_norm_g) * (1.0 + scale) + shift
    kv = (h @ w_kv).reshape(B_, S_, 6, N_KV, HEAD_DIM)
    kc_raw, vc_raw, ks, vs, kw, vw = [kv[:, :, i] for i in range(6)]
    n_cmp = (S_ - L_CMP) // D_CMP + 1
    idx = jnp.arange(n_cmp)[:, None] * D_CMP + jnp.arange(L_CMP)[None, :]

    def compress(raw, j):
        blk = raw[:, idx] + cmp_pos[j][None, None, :, None, :]
        blk = jnp.moveaxis(blk, 3, 2).reshape(B_, n_cmp, N_KV, L_CMP * HEAD_DIM)
        return jax.nn.gelu(blk @ cmp_w1[j] + cmp_b1[j]) @ cmp_w2[j] + cmp_b2[j]

    k_cmp = compress(kc_raw, 0)
    v_cmp = compress(vc_raw, 1)
    n_sel = S_ // L_SEL

    def to_blocks(t):
        return jnp.moveaxis(t, 2, 1).reshape(B_, N_KV, n_sel, L_SEL, HEAD_DIM)

    pad = ((0, 0), (WINDOW, 0), (0, 0), (0, 0))
    return (k_cmp, v_cmp, to_blocks(ks), to_blocks(vs), jnp.pad(kw, pad), jnp.pad(vw, pad))


def nsa_mix(h, w_in, w_out, k_cmp, v_cmp, ks_blk, vs_blk, kw_pad, vw_pad):
    B_, S_, _ = h.shape
    n_cmp = k_cmp.shape[1]
    n_sel = ks_blk.shape[2]
    k_sel = min(N_SELECT, n_sel)
    n_qb = S_ // Q_BLK
    proj = h @ w_in
    q = proj[..., :N_HEADS * HEAD_DIM].reshape(B_, S_, N_KV, HPG, HEAD_DIM) * (HEAD_DIM ** -0.5)
    gates = jax.nn.sigmoid(proj[..., N_HEADS * HEAD_DIM:]).reshape(B_, S_, N_KV, HPG, 3)
    ci = jnp.arange(n_cmp)[:, None] * D_CMP
    sj = jnp.arange(n_sel)[None, :] * L_SEL
    overlap = ((ci < sj + L_SEL) & (ci + L_CMP > sj)).astype(jnp.float32)
    cmp_end = jnp.arange(n_cmp) * D_CMP + L_CMP - 1
    sel_ids = jnp.arange(n_sel)
    b_ix = jnp.arange(B_)[:, None, None, None]
    g_ix = jnp.arange(N_KV)[None, :, None, None]

    def block(args):
        qb, q_blk, g_blk = args
        t = qb * Q_BLK + jnp.arange(Q_BLK)
        s = jnp.einsum('btghd,bngd->bghtn', q_blk, k_cmp).astype(jnp.float32)
        valid = cmp_end[None, :] <= t[:, None]
        p_cmp = jnp.where(valid, jax.nn.softmax(jnp.where(valid, s, NEG), axis=-1), 0.0)
        o_cmp = jnp.einsum('bghtn,bngd->btghd', p_cmp.astype(v_cmp.dtype), v_cmp)
        imp = jnp.einsum('bghtn,nj->bgtj', p_cmp, overlap)
        jt = t // L_SEL
        forced = (sel_ids[None, :] == 0) | (sel_ids[None, :] == jt[:, None]) | (sel_ids[None, :] == jt[:, None] - 1)
        imp = jnp.where(sel_ids[None, :] * L_SEL <= t[:, None], imp + jnp.where(forced, FORCE_BONUS, 0.0), NEG)
        _, top_idx = lax.top_k(imp, k_sel)
        k_g = ks_blk[b_ix, g_ix, top_idx].reshape(B_, N_KV, Q_BLK, k_sel * L_SEL, HEAD_DIM)
        v_g = vs_blk[b_ix, g_ix, top_idx].reshape(B_, N_KV, Q_BLK, k_sel * L_SEL, HEAD_DIM)
        kpos = (top_idx[..., None] * L_SEL + jnp.arange(L_SEL)).reshape(B_, N_KV, Q_BLK, k_sel * L_SEL)
        s = jnp.einsum('btghd,bgtkd->bghtk', q_blk, k_g).astype(jnp.float32)
        valid = (kpos <= t[None, None, :, None])[:, :, None]
        p = jax.nn.softmax(jnp.where(valid, s, NEG), axis=-1)
        o_slc = jnp.einsum('bghtk,bgtkd->btghd', p.astype(v_g.dtype), v_g)
        kw = lax.dynamic_slice_in_dim(kw_pad, qb * Q_BLK, WINDOW + Q_BLK, axis=1)
        vw = lax.dynamic_slice_in_dim(vw_pad, qb * Q_BLK, WINDOW + Q_BLK, axis=1)
        wpos = qb * Q_BLK - WINDOW + jnp.arange(WINDOW + Q_BLK)
        valid = (wpos[None, :] <= t[:, None]) & (wpos[None, :] > t[:, None] - WINDOW) & (wpos[None, :] >= 0)
        s = jnp.einsum('btghd,bsgd->bghts', q_blk, kw).astype(jnp.float32)
        p = jax.nn.softmax(jnp.where(valid, s, NEG), axis=-1)
        o_win = jnp.einsum('bghts,bsgd->btghd', p.astype(vw.dtype), vw)
        return o_cmp * g_blk[..., 0:1] + o_slc * g_blk[..., 1:2] + o_win * g_blk[..., 2:3]

    q_blocks = jnp.moveaxis(q.reshape(B_, n_qb, Q_BLK, N_KV, HPG, HEAD_DIM), 1, 0)
    g_blocks = jnp.moveaxis(gates.reshape(B_, n_qb, Q_BLK, N_KV, HPG, 3), 1, 0)
    o = lax.map(block, (jnp.arange(n_qb), q_blocks, g_blocks))
    o = jnp.moveaxis(o, 0, 1).reshape(B_, S_, N_HEADS * HEAD_DIM)
    return o @ w_out


def swiglu(h, w_gate, w_up, w_down):
    return (jax.nn.silu(h @ w_gate) * (h @ w_up)) @ w_down


def moe_swiglu(h, w_r, b_r, w_g, w_u, w_d):
    B_, S_, D_ = h.shape
    xt = h.reshape(-1, D_)
    T = xt.shape[0]
    n_assign = T * TOP_K
    logits = (xt @ w_r + b_r).astype(jnp.float32)
    top_v, top_e = lax.top_k(logits, TOP_K)
    gates = jax.nn.softmax(top_v, axis=-1).astype(h.dtype)
    e_flat = top_e.reshape(-1)
    g_flat = gates.reshape(-1)
    tok_flat = jnp.arange(n_assign) // TOP_K
    order = jnp.argsort(e_flat)
    se, stok, sg = e_flat[order], tok_flat[order], g_flat[order]
    counts = jnp.bincount(e_flat, length=N_EXPERTS)
    padded = (counts + MOE_BLOCK - 1) // MOE_BLOCK * MOE_BLOCK
    pend = jnp.cumsum(padded)
    pstart = pend - padded
    ustart = jnp.cumsum(counts) - counts
    dest = pstart[se] + jnp.arange(n_assign) - ustart[se]
    n_rows = -(-n_assign // MOE_BLOCK) * MOE_BLOCK + N_EXPERTS * MOE_BLOCK
    n_blk = n_rows // MOE_BLOCK
    x_buf = jnp.zeros((n_rows, D_), h.dtype).at[dest].set(xt[stok])
    blk_e = jnp.minimum(jnp.sum(jnp.arange(n_blk)[:, None] * MOE_BLOCK >= pend[None, :], axis=1), N_EXPERTS - 1)

    def expert_block(args):
        xb, e = args
        return swiglu(xb, w_g[e], w_u[e], w_d[e])

    y_buf = lax.map(expert_block, (x_buf.reshape(n_blk, MOE_BLOCK, D_), blk_e)).reshape(n_rows, D_)
    y = jax.ops.segment_sum(y_buf[dest] * sg[:, None], stok, num_segments=T)
    return y.reshape(B_, S_, D_)


def setup_inputs(seed: int = 0) -> dict:
    key = jax.random.key(seed)
    keys = iter(jax.random.split(key, 40))
    D = D_MODEL

    def nrm(shape, s):
        return jax.random.normal(next(keys), shape, jnp.float32) * s

    return {
        'x': nrm((BATCH, SEQ, D), 1.0),
        'c': nrm((BATCH, D), 1.0),
        'ada_w': nrm((DEPTH, 2, D, 3 * D), 0.5 * D ** -0.5),
        'ada_b': nrm((DEPTH, 2, 3 * D), 0.02),
        'norm_pre_g': 1.0 + nrm((DEPTH, 2, D), 0.02),
        'norm_post_g': 1.0 + nrm((DEPTH, 2, D), 0.02),
        'a_w_in': nrm((N_A, D, 2 * A_WIDTH), D ** -0.5),
        'a_ln_g': 1.0 + nrm((N_A, A_WIDTH), 0.02),
        'a_ln_b': nrm((N_A, A_WIDTH), 0.02),
        'a_ws': nrm((N_A, A_GROUPS, CHUNK, CHUNK), CHUNK ** -0.5),
        'a_bs': 1.0 + nrm((N_A, A_GROUPS, CHUNK), 0.02),
        'a_w_out': nrm((N_A, A_WIDTH, D), A_WIDTH ** -0.5),
        'kv_norm_g': 1.0 + nrm((D,), 0.02),
        'kv_ada_w': nrm((D, 2 * D), 0.5 * D ** -0.5),
        'kv_ada_b': nrm((2 * D,), 0.02),
        'w_kv': nrm((D, 6 * N_KV * HEAD_DIM), D ** -0.5),
        'cmp_pos': nrm((2, L_CMP, HEAD_DIM), 0.1),
        'cmp_w1': nrm((2, L_CMP * HEAD_DIM, CMP_HIDDEN), (L_CMP * HEAD_DIM) ** -0.5),
        'cmp_b1': nrm((2, CMP_HIDDEN), 0.02),
        'cmp_w2': nrm((2, CMP_HIDDEN, HEAD_DIM), CMP_HIDDEN ** -0.5),
        'cmp_b2': nrm((2, HEAD_DIM), 0.02),
        'b_w_in': nrm((N_B, D, N_HEADS * HEAD_DIM + 3 * N_HEADS), D ** -0.5),
        'b_w_out': nrm((N_B, N_HEADS * HEAD_DIM, D), (N_HEADS * HEAD_DIM) ** -0.5),
        'ffn_w_gate': nrm((N_DENSE, D, D_FF), D ** -0.5),
        'ffn_w_up': nrm((N_DENSE, D, D_FF), D ** -0.5),
        'ffn_w_down': nrm((N_DENSE, D_FF, D), D_FF ** -0.5),
        'moe_router': nrm((N_MOE, D, N_EXPERTS), D ** -0.5),
        'moe_router_b': nrm((N_MOE, N_EXPERTS), 0.01),
        'moe_w_gate': nrm((N_MOE, N_EXPERTS, D, D_EXPERT), D ** -0.5),
        'moe_w_up': nrm((N_MOE, N_EXPERTS, D, D_EXPERT), D ** -0.5),
        'moe_w_down': nrm((N_MOE, N_EXPERTS, D_EXPERT, D), D_EXPERT ** -0.5),
    }


def reference(x, c, ada_w, ada_b, norm_pre_g, norm_post_g, a_w_in, a_ln_g, a_ln_b, a_ws, a_bs, a_w_out, kv_norm_g, kv_ada_w, kv_ada_b, w_kv, cmp_pos, cmp_w1, cmp_b1, cmp_w2, cmp_b2, b_w_in, b_w_out, ffn_w_gate, ffn_w_up, ffn_w_down, moe_router, moe_router_b, moe_w_gate, moe_w_up, moe_w_down):
    c_act = jax.nn.silu(c)
    shared_kv = None
    for layer in range(DEPTH):
        shift, scale, gate = ada_mod(c_act, ada_w[layer, 0], ada_b[layer, 0], 3)
        h = rms_norm(x, norm_pre_g[layer, 0]) * (1.0 + scale) + shift
        if layer < N_A:
            y = gmlp_mix(h, a_w_in[layer], a_ln_g[layer], a_ln_b[layer], a_ws[layer], a_bs[layer], a_w_out[layer])
        else:
            if layer == N_A:
                shared_kv = nsa_shared_kv(x, c_act, kv_norm_g, kv_ada_w, kv_ada_b, w_kv, cmp_pos, cmp_w1, cmp_b1, cmp_w2, cmp_b2)
            i = layer - N_A
            y = nsa_mix(h, b_w_in[i], b_w_out[i], *shared_kv)
        x = x + gate * rms_norm(y, norm_post_g[layer, 0])
        shift, scale, gate = ada_mod(c_act, ada_w[layer, 1], ada_b[layer, 1], 3)
        h = rms_norm(x, norm_pre_g[layer, 1]) * (1.0 + scale) + shift
        j = layer // 2
        if layer % 2 == 0:
            y = swiglu(h, ffn_w_gate[j], ffn_w_up[j], ffn_w_down[j])
        else:
            y = moe_swiglu(h, moe_router[j], moe_router_b[j], moe_w_gate[j], moe_w_up[j], moe_w_down[j])
        x = x + gate * rms_norm(y, norm_post_g[layer, 1])
    return x
```

```cpp
#include <hip/hip_runtime.h>
#include <cstdio>
#include <cstdint>
namespace pg8 {
#define PG8_LAS __attribute__((address_space(3)))
typedef unsigned short bf16_t;
typedef short bf16x8 __attribute__((ext_vector_type(8)));
typedef float f32x4 __attribute__((ext_vector_type(4)));
typedef float f32x2 __attribute__((ext_vector_type(2)));
typedef unsigned u32x4 __attribute__((ext_vector_type(4)));
typedef unsigned u32x2 __attribute__((ext_vector_type(2)));
constexpr int BM = 256, BK = 64, HALF = 128, HTB = HALF * BK * 2  , STAGE_BYTES = 8 * HTB, NXCD = 8, WGM = 8;

__host__ __device__ __forceinline__ int lds_byte(int r, int c) { const int st = (r >> 4) * 2 + (c >> 5), rr = r & 15, cc = c & 31, ob = rr * 64 + cc * 2; return st * 1024 + (ob ^ (((ob >> 9) & 1) << 5)); }
__host__ __device__ __forceinline__ void stage_rc(int b, int& R, int& C) { const int st = b / 1024, sb = b % 1024, swz = sb ^ (((sb >> 9) & 1) << 5); R = (st >> 1) * 16 + swz / 64; C = (st & 1) * 32 + (swz % 64) / 2; }
__host__ __device__ __forceinline__ int perm32(int rho) { const int n = rho >> 4, i = rho & 15; return 8 * (i >> 2) + 4 * n + (i & 3); }

__host__ __device__ __forceinline__ int lds_byte8(int r, int cb) { return r * 128 + ((((cb >> 5) ^ ((r >> 1) & 3)) & 3) << 5) + (cb & 31); }
__host__ __device__ __forceinline__ void stage_rc8(int b, int& R, int& Cb) { R = b >> 7; Cb = ((((b >> 5) & 3) ^ ((R >> 1) & 3)) << 5) + (b & 31); }
struct Unit { int pm, pn; };
struct Gemm { const char* A; const char* Bt; int K; unsigned lda, ldb, kstepA; };

__device__ __forceinline__ bool tile_from_L(long L, int nM, int nN, Unit& u);
__device__ __forceinline__ bool tile_order(int i, int G, int c, int nM, int nN, Unit& u) { return tile_from_L((long)i * G + c, nM, nN, u); }
__device__ __forceinline__ bool tile_from_L(long L, int nM, int nN, Unit& u) {
    const int nwg = nM * nN; if (L >= nwg) return false;
    int wgid = (int)L; { const int q = nwg / NXCD, r = nwg % NXCD, xcd = wgid % NXCD, off = wgid / NXCD; wgid = (xcd < r ? xcd * (q + 1) : r * (q + 1) + (xcd - r) * q) + off; }
    const int nig = WGM * nN, gid = wgid / nig, fm = gid * WGM, gsz = (nM - fm) < WGM ? (nM - fm) : WGM;
    u.pm = fm + ((wgid % nig) % gsz); u.pn = (wgid % nig) / gsz; return true;
}
struct StaticOrder {
    int nM, nN, G, c;
    __device__ __forceinline__ void init(int M, int N, int G_, int c_) { nM = M / BM; nN = N / BM; G = G_; c = c_; }
    __device__ __forceinline__ bool next(int i, Unit& u) const { return tile_order(i, G, c, nM, nN, u); }
    __device__ __forceinline__ const char* a_ptr(const Gemm& g, const Unit& u) const { return g.A + (size_t)u.pm * ((size_t)BM * g.lda * 2); }
    __device__ __forceinline__ const char* b_ptr(const Gemm& g, const Unit& u) const { return g.Bt + (size_t)u.pn * ((size_t)BM * g.ldb * 2); }
};

typedef __bf16 bf16x2_hw __attribute__((ext_vector_type(2)));
typedef float f32x2_hw __attribute__((ext_vector_type(2)));
__device__ __forceinline__ unsigned cvt_pk_bf16(float lo, float hi) { return __builtin_bit_cast(unsigned, __builtin_convertvector((f32x2_hw){lo, hi}, bf16x2_hw)); }
#ifndef MK_WT
#define MK_WT 1
#endif
__device__ __forceinline__ void st16_out(void* p, u32x4 v) { if (MK_WT) asm volatile("global_store_dwordx4 %0, %1, off sc1\n\ts_nop 1" :: "v"(p), "v"(v) : "memory");     else *(u32x4*)p = v; }
__device__ __forceinline__ void st8_out(void* p, u32x2 v) { if (MK_WT) asm volatile("global_store_dwordx2 %0, %1, off sc1" :: "v"(p), "v"(v) : "memory"); else *(u32x2*)p = v; }
__device__ __forceinline__ float gelu_tanh(float x) {
    const float u = x * (1.5957691216f + 0.0713548163f * x * x);
    const float e = __builtin_amdgcn_exp2f(-1.4426950409f * u);
    return x * __builtin_amdgcn_rcpf(1.0f + e);
}
__device__ __forceinline__ f32x2_hw gelu_tanh2(f32x2_hw x) {
    const f32x2_hw t = x * (x * x * (-1.4426950409f * 0.0713548163f) + (-1.4426950409f * 1.5957691216f));
    f32x2_hw d; d.x = __builtin_amdgcn_exp2f(t.x); d.y = __builtin_amdgcn_exp2f(t.y); d = d + 1.0f;
    f32x2_hw r; r.x = __builtin_amdgcn_rcpf(d.x); r.y = __builtin_amdgcn_rcpf(d.y);
    return x * r;
}
__device__ __forceinline__ f32x2_hw silu_mul2(f32x2_hw g, f32x2_hw u, float k1  , float k2  ) {
    const f32x2_hw t = g * k1; f32x2_hw d; d.x = __builtin_amdgcn_exp2f(t.x); d.y = __builtin_amdgcn_exp2f(t.y); d = d + 1.0f;
    f32x2_hw r; r.x = __builtin_amdgcn_rcpf(d.x); r.y = __builtin_amdgcn_rcpf(d.y);
    return (g * u) * (r * k2);
}
__device__ __forceinline__ float silu_f(float x) { return x * __builtin_amdgcn_rcpf(1.0f + __builtin_amdgcn_exp2f(-1.4426950409f * x)); }
__device__ __forceinline__ float sigmoid_f(float x) { return __builtin_amdgcn_rcpf(1.0f + __builtin_amdgcn_exp2f(-1.4426950409f * x)); }

template <int ACT  > struct EpiBf16 {
    static constexpr bool PERM = true;
    bf16_t* O; int ldc; const float* bias0; int split_cols; size_t split_stride; float scale; int brow_shift, brow_stride;
    __device__ __forceinline__ void operator()(const f32x4 (&acc)[2][2][4][2], const Unit& u, int wr, int wc, int fr, int fq) const {
        const float* bias = bias0; if (bias0 && brow_shift >= 0) bias = bias0 + (u.pm >> brow_shift) * brow_stride;
        const int row0 = u.pm * BM + wr * 64 + fr; int colt = u.pn * BM; bf16_t* base = O;
        if (split_cols) { const int t = colt / split_cols; base += (size_t)t * split_stride; colt -= t * split_cols; }
        const int col0 = colt + wc * 32 + 8 * fq, bcol0 = u.pn * BM + wc * 32 + 8 * fq;
        f32x4 bv[2][2];
#pragma unroll
        for (int bj = 0; bj < 2; ++bj)
#pragma unroll
            for (int n = 0; n < 2; ++n) bv[bj][n] = bias ? *(const f32x4*)(bias + bcol0 + bj * HALF + 4 * n) : (f32x4){0.f, 0.f, 0.f, 0.f};
#pragma unroll
        for (int ai = 0; ai < 2; ++ai)
#pragma unroll
            for (int m = 0; m < 4; ++m) { bf16_t* rowp = base + (size_t)(row0 + ai * HALF + m * 16) * ldc + col0;
#pragma unroll
                for (int bj = 0; bj < 2; ++bj) { f32x4 v0 = acc[ai][bj][m][0], v1 = acc[ai][bj][m][1]; if (bias) { v0 = v0 + bv[bj][0]; v1 = v1 + bv[bj][1]; }
                    if (ACT == 1) {
                        const f32x2_hw a0 = gelu_tanh2((f32x2_hw){v0[0], v0[1]}), a1 = gelu_tanh2((f32x2_hw){v0[2], v0[3]}), a2 = gelu_tanh2((f32x2_hw){v1[0], v1[1]}), a3 = gelu_tanh2((f32x2_hw){v1[2], v1[3]});
                        v0 = (f32x4){a0.x, a0.y, a1.x, a1.y}; v1 = (f32x4){a2.x, a2.y, a3.x, a3.y}; }
                    v0 = v0 * scale; v1 = v1 * scale; u32x4 w; w.x = cvt_pk_bf16(v0[0], v0[1]); w.y = cvt_pk_bf16(v0[2], v0[3]); w.z = cvt_pk_bf16(v1[0], v1[1]); w.w = cvt_pk_bf16(v1[2], v1[3]);
                    st16_out(rowp + bj * HALF, w); } }
    }
};
struct EpiSwiglu {
    static constexpr bool PERM = true;
    bf16_t* O; int ldc;
    __device__ __forceinline__ void operator()(const f32x4 (&acc)[2][2][4][2], const Unit& u, int wr, int wc, int fr, int fq) const {
        const int row0 = u.pm * BM + wr * 64 + fr, col0 = u.pn * HALF + wc * 32 + 8 * fq;
#pragma unroll
        for (int ai = 0; ai < 2; ++ai)
#pragma unroll
            for (int m = 0; m < 4; ++m) { bf16_t* rowp = O + (size_t)(row0 + ai * HALF + m * 16) * ldc + col0;
                f32x4 v0, v1;
#pragma unroll
                for (int j = 0; j < 4; j += 2) { const f32x2_hw a = silu_mul2((f32x2_hw){acc[ai][0][m][0][j], acc[ai][0][m][0][j + 1]}, (f32x2_hw){acc[ai][1][m][0][j], acc[ai][1][m][0][j + 1]}, -1.4426950409f, 1.0f),
                                                                b = silu_mul2((f32x2_hw){acc[ai][0][m][1][j], acc[ai][0][m][1][j + 1]}, (f32x2_hw){acc[ai][1][m][1][j], acc[ai][1][m][1][j + 1]}, -1.4426950409f, 1.0f);
                    v0[j] = a.x; v0[j + 1] = a.y; v1[j] = b.x; v1[j + 1] = b.y; }
                u32x4 w; w.x = cvt_pk_bf16(v0[0], v0[1]); w.y = cvt_pk_bf16(v0[2], v0[3]); w.z = cvt_pk_bf16(v1[0], v1[1]); w.w = cvt_pk_bf16(v1[2], v1[3]);
                st16_out(rowp, w); }
    }
};
struct EpiSwigluS {
    static constexpr bool PERM = true;
    bf16_t* O; int ldc; float inscale;
    __device__ __forceinline__ void operator()(const f32x4 (&acc)[2][2][4][2], const Unit& u, int wr, int wc, int fr, int fq) const {
        const int row0 = u.pm * BM + wr * 64 + fr, col0 = u.pn * HALF + wc * 32 + 8 * fq;
#pragma unroll
        for (int ai = 0; ai < 2; ++ai)
#pragma unroll
            for (int m = 0; m < 4; ++m) { bf16_t* rowp = O + (size_t)(row0 + ai * HALF + m * 16) * ldc + col0;
                f32x4 v0, v1;
                float k1 = -1.4426950409f * inscale, k2 = inscale * inscale;
                asm volatile("" : "+s"(k1), "+s"(k2));
#pragma unroll
                for (int j = 0; j < 4; j += 2) { const f32x2_hw a = silu_mul2((f32x2_hw){acc[ai][0][m][0][j], acc[ai][0][m][0][j + 1]}, (f32x2_hw){acc[ai][1][m][0][j], acc[ai][1][m][0][j + 1]}, k1, k2),
                                                                b = silu_mul2((f32x2_hw){acc[ai][0][m][1][j], acc[ai][0][m][1][j + 1]}, (f32x2_hw){acc[ai][1][m][1][j], acc[ai][1][m][1][j + 1]}, k1, k2);
                    v0[j] = a.x; v0[j + 1] = a.y; v1[j] = b.x; v1[j + 1] = b.y; }
                u32x4 w; w.x = cvt_pk_bf16(v0[0], v0[1]); w.y = cvt_pk_bf16(v0[2], v0[3]); w.z = cvt_pk_bf16(v1[0], v1[1]); w.w = cvt_pk_bf16(v1[2], v1[3]);
                st16_out(rowp, w); }
    }
};
struct EpiQG {
    static constexpr bool PERM = true;
    bf16_t* Q; float* G; float qscale;
    __device__ __forceinline__ void operator()(const f32x4 (&acc)[2][2][4][2], const Unit& u, int wr, int wc, int fr, int fq) const {
        const int row0 = u.pm * BM + wr * 64 + fr;
        if (u.pn < 4) {
            const int col0 = u.pn * BM + wc * 32 + 8 * fq;
#pragma unroll
            for (int ai = 0; ai < 2; ++ai)
#pragma unroll
                for (int m = 0; m < 4; ++m) { bf16_t* rowp = Q + (size_t)(row0 + ai * HALF + m * 16) * 1024 + col0;
#pragma unroll
                    for (int bj = 0; bj < 2; ++bj) { const f32x4 v0 = acc[ai][bj][m][0] * qscale, v1 = acc[ai][bj][m][1] * qscale;
                        u32x4 w; w.x = cvt_pk_bf16(v0[0], v0[1]); w.y = cvt_pk_bf16(v0[2], v0[3]); w.z = cvt_pk_bf16(v1[0], v1[1]); w.w = cvt_pk_bf16(v1[2], v1[3]);
                        st16_out(rowp + bj * HALF, w); } }
        } else {
            const int c0 = wc * 32 + 8 * fq;
            if (c0 < 48) {
#pragma unroll
                for (int ai = 0; ai < 2; ++ai)
#pragma unroll
                    for (int m = 0; m < 4; ++m) { float* rowp = G + (size_t)(row0 + ai * HALF + m * 16) * 48 + c0;
                        f32x4 v0, v1;
#pragma unroll
                        for (int j = 0; j < 4; ++j) { v0[j] = sigmoid_f(acc[ai][0][m][0][j]); v1[j] = sigmoid_f(acc[ai][0][m][1][j]); }
                        st16_out(rowp, __builtin_bit_cast(u32x4, v0)); st16_out(rowp + 4, __builtin_bit_cast(u32x4, v1)); }
            }
        }
    }
};

typedef int v8i __attribute__((ext_vector_type(8)));
typedef int v4i __attribute__((ext_vector_type(4)));
__device__ __forceinline__ float clamp448(float x) { return __builtin_amdgcn_fmed3f(x, -448.0f, 448.0f); }
__device__ __forceinline__ unsigned pk4_fp8(float a, float b, float c, float d) {
    unsigned w; a = clamp448(a); b = clamp448(b); c = clamp448(c); d = clamp448(d);
    asm volatile("v_cvt_pk_fp8_f32 %0, %1, %2" : "=v"(w) : "v"(a), "v"(b));
    asm volatile("v_cvt_pk_fp8_f32 %0, %1, %2 op_sel:[0,0,1]" : "+v"(w) : "v"(c), "v"(d));
    return w; }
struct EpiSwigluF8 {
    static constexpr bool PERM = true;
    unsigned char* O; int ldc; float inscale, outscale; unsigned* cnt; int npan;
    __device__ __forceinline__ void operator()(const f32x4 (&acc)[2][2][4][2], const Unit& u, int wr, int wc, int fr, int fq) const {
        const int row0 = u.pm * BM + wr * 64 + fr, col0 = u.pn * HALF + wc * 32 + 8 * fq;
#pragma unroll
        for (int ai = 0; ai < 2; ++ai)
#pragma unroll
            for (int m = 0; m < 4; ++m) { unsigned char* rowp = O + (size_t)(row0 + ai * HALF + m * 16) * ldc + col0;
                f32x4 v0, v1;
                float k1 = -1.4426950409f * inscale, k2 = inscale * inscale * outscale;
                asm volatile("" : "+s"(k1), "+s"(k2));
#pragma unroll
                for (int j = 0; j < 4; j += 2) { const f32x2_hw a = silu_mul2((f32x2_hw){acc[ai][0][m][0][j], acc[ai][0][m][0][j + 1]}, (f32x2_hw){acc[ai][1][m][0][j], acc[ai][1][m][0][j + 1]}, k1, k2),
                                                                b = silu_mul2((f32x2_hw){acc[ai][0][m][1][j], acc[ai][0][m][1][j + 1]}, (f32x2_hw){acc[ai][1][m][1][j], acc[ai][1][m][1][j + 1]}, k1, k2);
                    v0[j] = a.x; v0[j + 1] = a.y; v1[j] = b.x; v1[j + 1] = b.y; }
                u32x2 w; w.x = pk4_fp8(v0[0], v0[1], v0[2], v0[3]); w.y = pk4_fp8(v1[0], v1[1], v1[2], v1[3]);
                st8_out(rowp, w); }
        if (u.pm < npan) {
            asm volatile("s_waitcnt vmcnt(0)" ::: "memory");
            if (fr == 0 && fq == 0) __hip_atomic_fetch_add(cnt + u.pm, 1u, __ATOMIC_RELAXED, __HIP_MEMORY_SCOPE_AGENT);
        }
    }
};
template <class Epi, class Sched, bool ALIGN_EPI = true, bool F8 = false>
__device__ __forceinline__ void gemm_phase(const int tid, PG8_LAS unsigned char* lds, const Gemm g, const Sched& S, const Epi& E) {
    const int wid = __builtin_amdgcn_readfirstlane(tid >> 6), lane = tid & 63, wr = wid >> 2, wc = wid & 3, fr = lane & 15, fq = lane >> 4;
    const int K = g.K, nt = K / BK;
    unsigned voffA[2], voffB[2];
#pragma unroll
    for (int i = 0; i < 2; ++i) { int R, C; if constexpr (F8) { int Cb; stage_rc8(tid * 16 + i * 8192, R, Cb); C = Cb >> 1; } else stage_rc(tid * 16 + i * 8192, R, C);
        const int Rb = Epi::PERM ? ((R & ~31) + perm32(R & 31)) : R;
        voffA[i] = (unsigned)(R * g.lda + C) * 2u; voffB[i] = (unsigned)(Rb * g.ldb + C) * 2u; }
    const size_t kstepA = (size_t)g.kstepA, kstepB = (size_t)(BK * 2);
    const size_t hstepA = (size_t)HALF * g.lda * 2, hstepB = (size_t)HALF * g.ldb * 2;
    const unsigned ldsw = (unsigned)wid * 1024u;
    const int aoff = F8 ? lds_byte8(wr * 64 + fr, fq * 32) : lds_byte(wr * 64 + fr, fq * 8), boff = F8 ? lds_byte8(wc * 32 + fr, fq * 32) : lds_byte(wc * 32 + fr, fq * 8);
#define PG8_SA(b, h) (((b) * 2 + (h)) * HTB)
#define PG8_SB(b, h) ((4 + (b) * 2 + (h)) * HTB)
#define PG8_STAGE(bufoff, gbase, voff) do { _Pragma("unroll") for (int _i = 0; _i < 2; ++_i) \
        __builtin_amdgcn_global_load_lds((const unsigned*)((const char*)(gbase) + (voff)[_i]), (PG8_LAS unsigned*)(lds + (bufoff) + ldsw + _i * 8192), 16, 0, 0); } while (0)
#define PG8_LDA(dst, b, h) do { _Pragma("unroll") for (int m = 0; m < 4; ++m) { if constexpr (F8) dst##8[m] = *(const PG8_LAS v8i*)(lds + PG8_SA(b, h) + aoff + m * 2048); else { _Pragma("unroll") for (int k = 0; k < 2; ++k) dst[m][k] = *(const PG8_LAS bf16x8*)(lds + PG8_SA(b, h) + aoff + m * 2048 + k * 1024); } } } while (0)
#define PG8_LDB(dst, b, h) do { _Pragma("unroll") for (int n = 0; n < 2; ++n) { if constexpr (F8) dst##8[n] = *(const PG8_LAS v8i*)(lds + PG8_SB(b, h) + boff + n * 2048); else { _Pragma("unroll") for (int k = 0; k < 2; ++k) dst[n][k] = *(const PG8_LAS bf16x8*)(lds + PG8_SB(b, h) + boff + n * 2048 + k * 1024); } } } while (0)
#define PG8_MMA(ai, bj, At, Bt) do { __builtin_amdgcn_s_setprio(1); _Pragma("unroll") for (int m = 0; m < 4; ++m) _Pragma("unroll") for (int n = 0; n < 2; ++n) { \
        if constexpr (F8) { asm volatile("v_mfma_scale_f32_16x16x128_f8f6f4 %0, %1, %2, %0, %3, %3 op_sel_hi:[0,0,0]" : "+v"(acc[ai][bj][m][n]) : "v"(Bt##8[n]), "v"(At##8[m]), "v"(one_scale)); } \
        else { _Pragma("unroll") for (int k = 0; k < 2; ++k) acc[ai][bj][m][n] = __builtin_amdgcn_mfma_f32_16x16x32_bf16(Bt[n][k], At[m][k], acc[ai][bj][m][n], 0, 0, 0); } } __builtin_amdgcn_s_setprio(0); } while (0)
#define PG8_WAIT_V(n) asm volatile("s_waitcnt vmcnt(" #n ")" ::: "memory")
#define PG8_WAIT_L(n) asm volatile("s_waitcnt lgkmcnt(" #n ")" ::: "memory")
#define PG8_BAR __builtin_amdgcn_s_barrier()
#define PG8_SCHED __builtin_amdgcn_sched_barrier(0)
    Unit cur, nxt; int ui = 0;
    if (!S.next(0, cur)) return;
    f32x4 acc[2][2][4][2];
#pragma unroll
    for (int a = 0; a < 2; ++a)
#pragma unroll
        for (int b = 0; b < 2; ++b)
#pragma unroll
            for (int m = 0; m < 4; ++m)
#pragma unroll
                for (int n = 0; n < 2; ++n) acc[a][b][m][n] = (f32x4){0.f, 0.f, 0.f, 0.f};
    bf16x8 At[4][2], B0[2][2], B1[2][2]; v8i At8[4], B08[2], B18[2]; int one_scale = 0x7f7f7f7f; asm volatile("" : "+v"(one_scale));
    const char* cA = S.a_ptr(g, cur); const char* cB = S.b_ptr(g, cur);
    PG8_STAGE(PG8_SB(0, 0), cB, voffB); PG8_STAGE(PG8_SB(0, 1), cB + hstepB, voffB); PG8_STAGE(PG8_SA(0, 0), cA, voffA); PG8_STAGE(PG8_SA(0, 1), cA + hstepA, voffA);
    if (wr == 1) PG8_BAR;
    PG8_WAIT_V(2); PG8_BAR;
    PG8_STAGE(PG8_SB(1, 0), cB + kstepB, voffB); PG8_STAGE(PG8_SA(1, 0), cA + kstepA, voffA); PG8_STAGE(PG8_SB(1, 1), cB + hstepB + kstepB, voffB);
    PG8_WAIT_V(6); PG8_BAR;
    for (;;) {
        const bool has_next = S.next(ui + 1, nxt);
        const char* nA = has_next ? S.a_ptr(g, nxt) : cA; const char* nB = has_next ? S.b_ptr(g, nxt) : cB;
#pragma nounroll
        for (int t = 0; t < nt; t += 2) {
            const bool last = (t == nt - 2);
            const char* a1 = cA + (size_t)(t + 1) * kstepA;
            const char* a2 = last ? nA : cA + (size_t)(t + 2) * kstepA; const char* b2 = last ? nB : cB + (size_t)(t + 2) * kstepB;
            const char* a3 = a2 + kstepA; const char* b3 = b2 + kstepB;
            PG8_LDB(B0, 0, 0); PG8_LDB(B1, 0, 1); PG8_SCHED; PG8_LDA(At, 0, 0); PG8_STAGE(PG8_SA(1, 1), a1 + hstepA, voffA);
            PG8_WAIT_V(8); PG8_WAIT_L(0); PG8_BAR; PG8_MMA(0, 0, At, B0); PG8_MMA(0, 1, At, B1); PG8_BAR; PG8_SCHED;
            PG8_LDA(At, 0, 1); PG8_STAGE(PG8_SB(0, 0), b2, voffB); PG8_STAGE(PG8_SB(0, 1), b2 + hstepB, voffB); PG8_STAGE(PG8_SA(0, 0), a2, voffA);
            PG8_WAIT_V(8); PG8_WAIT_L(0); PG8_BAR; PG8_MMA(1, 0, At, B0); PG8_MMA(1, 1, At, B1); PG8_BAR; PG8_SCHED;
            PG8_LDB(B0, 1, 0); PG8_LDB(B1, 1, 1); PG8_SCHED; PG8_LDA(At, 1, 0); PG8_STAGE(PG8_SA(0, 1), a2 + hstepA, voffA);
            PG8_WAIT_V(8); PG8_WAIT_L(0); PG8_BAR; PG8_MMA(0, 0, At, B0); PG8_MMA(0, 1, At, B1); PG8_BAR; PG8_SCHED;
            PG8_LDA(At, 1, 1); PG8_STAGE(PG8_SB(1, 0), b3, voffB); PG8_STAGE(PG8_SB(1, 1), b3 + hstepB, voffB); PG8_STAGE(PG8_SA(1, 0), a3, voffA);
            PG8_WAIT_V(8); PG8_WAIT_L(0); PG8_BAR; PG8_MMA(1, 0, At, B0); PG8_MMA(1, 1, At, B1); PG8_BAR; PG8_SCHED;
        }
        if constexpr (ALIGN_EPI) { if (wr == 0) PG8_BAR; }
        if constexpr (F8) asm volatile("s_nop 15\n\ts_nop 15\n\ts_nop 15" ::: "memory");
        E(acc, cur, wr, wc, fr, fq);
        if (!has_next) break;
#pragma unroll
        for (int a = 0; a < 2; ++a)
#pragma unroll
            for (int b = 0; b < 2; ++b)
#pragma unroll
                for (int m = 0; m < 4; ++m)
#pragma unroll
                    for (int n = 0; n < 2; ++n) acc[a][b][m][n] = (f32x4){0.f, 0.f, 0.f, 0.f};
        cur = nxt; cA = nA; cB = nB; ++ui;
        if constexpr (ALIGN_EPI) { if (wr == 1) PG8_BAR; }
    }
    PG8_WAIT_V(0);
    if constexpr (!ALIGN_EPI) { if (wr == 0) PG8_BAR; }
    PG8_BAR;
#undef PG8_SA
#undef PG8_SB
#undef PG8_STAGE
#undef PG8_LDA
#undef PG8_LDB
#undef PG8_MMA
#undef PG8_WAIT_V
#undef PG8_WAIT_L
#undef PG8_BAR
#undef PG8_SCHED
}
}
constexpr int NWAVES = 8;
constexpr int M = 16384, D = 1024, DEPTH = 4;
constexpr int A_W = 2048, A_G = 8, CHUNK = 128;
constexpr int NH = 16, NKV = 4, HPG = 4, HD = 64;
constexpr int N_CMP = 1023, NCMP_P = 1024;
constexpr int DFF = 2816, NEXP = 8, DEXP = 3584, MOE_BLK = 256;
constexpr int MOE_ROWS = 2 * M + NEXP * MOE_BLK;
constexpr int NQG = 1280;
constexpr float EPS = 1e-6f;
constexpr int MODC = 8 * 3072 + 2048 + 512;
constexpr int MODKS = 16;

constexpr size_t MiB = 1u << 20;
constexpr size_t WS_CTL = 0, CTL_ZERO_BYTES = 1 * MiB;
constexpr size_t WS_MODP = 1 * MiB;
constexpr size_t WS_MOD = 3 * MiB + 8192;
constexpr size_t WS_CB1 = 3 * MiB;
constexpr size_t WS_ROUTE = 3 * MiB + 131072;
constexpr size_t WS_W = 4 * MiB;
constexpr size_t W_AIN = WS_W;
constexpr size_t W_AOUT = W_AIN + (size_t)2 * 4096 * 1024 * 2;
constexpr size_t W_KV = W_AOUT + (size_t)2 * 1024 * 2048 * 2;
constexpr size_t W_C1 = W_KV + (size_t)1536 * 1024 * 2;
constexpr size_t W_C2 = W_C1 + (size_t)2 * 256 * 2048 * 2;
constexpr size_t W_BIN = W_C2 + (size_t)2 * 64 * 256 * 2;
constexpr size_t W_BOUT = W_BIN + (size_t)2 * NQG * 1024 * 2;
constexpr size_t W_FGU = W_BOUT + (size_t)2 * 1024 * 1024 * 2;
constexpr size_t W_FD = W_FGU + (size_t)2 * 5632 * 1024 * 2;
constexpr size_t W_MGU = W_FD + (size_t)2 * 1024 * 2816 * 2;
constexpr size_t W_MD = W_MGU + (size_t)16 * 7168 * 1024 * 2;
constexpr size_t W_END = W_MD + (size_t)16 * 1024 * 3584 * 2;
constexpr size_t WS_H = (W_END + MiB - 1) / MiB * MiB;
constexpr size_t WS_Y = WS_H + 32 * MiB;
constexpr size_t WS_KV = WS_Y + 32 * MiB;
constexpr size_t WS_VT = WS_KV + 49 * MiB;
constexpr size_t WS_KCMP = WS_VT + 16 * MiB;
constexpr size_t WS_VCMPT = WS_KCMP + 512 * 1024;
constexpr size_t WS_X16 = WS_VCMPT + 512 * 1024;
constexpr size_t WS_UNI = WS_X16 + 32 * MiB;
constexpr size_t WS_U = WS_UNI, WS_V = WS_U + 64 * MiB, WS_UM = WS_V + 64 * MiB;
constexpr size_t WS_ACT = WS_UNI;
constexpr float MOE_SW_GU = 32.0f, MOE_SW_D = 64.0f, MOE_SA = 4.0f;
#ifndef FFN_F8
#define FFN_F8 1
#endif
#ifndef M3_SPLIT
#define M3_SPLIT 0
#endif
constexpr size_t WS_XBUF = WS_UNI;
constexpr size_t WS_XBUF2 = WS_XBUF;
constexpr size_t WS_YBUF = WS_XBUF + 128 * MiB;
constexpr size_t WS_ACTM = WS_YBUF + 68 * MiB;
constexpr size_t WS_HKV = WS_ACTM;
constexpr size_t WS_Q = WS_UNI + 32 * MiB;
constexpr size_t WS_G = WS_Q + 32 * MiB;
constexpr size_t WS_O = WS_G + 4 * MiB;
constexpr size_t WS_HID = WS_O + 32 * MiB;
constexpr size_t WS_END = WS_UNI + 374 * MiB;
static_assert(WS_ACTM + (size_t)MOE_ROWS * DEXP <= WS_END && (size_t)MOE_ROWS * 1024 * 2 <= 68 * MiB && (size_t)8 * 16384 * 1024 <= 128 * MiB && (size_t)(M + 64) * 1536 * 2 <= 49 * MiB, "ws map");
static_assert((size_t)MODKS * MODC * 4 <= 2 * MiB, "modp");

constexpr int CW_TMO = 0, CW_CODE = 1;
constexpr int CW_BAR = 4096;
constexpr int CW_KMAX = 12288;
constexpr int CW_EARLY = 14336;
__host__ __device__ __forceinline__ int moe_early_tiles(int nM, int G) { const int e = (4 * nM) % G; return (G == 256 && e <= 64 && 4 * nM >= 2 * G) ? e : 0; }
constexpr int CW_MOE = 8192;

constexpr int RING_OFF = 0, RING_BYTES = 131072;
constexpr int LDSCTL_OFF = RING_BYTES, MISC_OFF = LDSCTL_OFF + 320;
constexpr int LDS_BYTES = 147456;
constexpr int SLC_BM_OFF = RING_BYTES + 1024, SLC_MREF_OFF = SLC_BM_OFF + 2048, SLC_LACC_OFF = SLC_MREF_OFF + 1024;
static_assert(SLC_LACC_OFF + 4096 <= LDS_BYTES && MISC_OFF + 128 <= SLC_BM_OFF, "LDS map");

#define GAS __attribute__((address_space(1)))
#define LAS __attribute__((address_space(3)))
typedef unsigned short bf16;
typedef unsigned v4u __attribute__((ext_vector_type(4)));
typedef unsigned v2u __attribute__((ext_vector_type(2)));
typedef float f32x4 __attribute__((ext_vector_type(4)));
typedef short bf16x8 __attribute__((ext_vector_type(8)));
typedef short bf16x4 __attribute__((ext_vector_type(4)));
typedef GAS unsigned gu32;
#define RLX_AGENT __ATOMIC_RELAXED, __HIP_MEMORY_SCOPE_AGENT
#define LDS_WAIT() asm volatile("s_waitcnt lgkmcnt(0)" ::: "memory")
#define VM_WAIT() asm volatile("s_waitcnt vmcnt(0)" ::: "memory")
__device__ __forceinline__ float shx(float v, int lane, int m) { return __builtin_bit_cast(float, __builtin_amdgcn_ds_bpermute((lane ^ m) << 2, __builtin_bit_cast(int, v))); }
__device__ __forceinline__ float shl_from(float v, int src_lane) { return __builtin_bit_cast(float, __builtin_amdgcn_ds_bpermute(src_lane << 2, __builtin_bit_cast(int, v))); }
__device__ __forceinline__ unsigned f2bf(float f) { unsigned u = __builtin_bit_cast(unsigned, f); return (u + 0x7fffu + ((u >> 16) & 1u)) >> 16; }
__device__ __forceinline__ unsigned pk2(float lo, float hi) { return pg8::cvt_pk_bf16(lo, hi); }
__device__ __forceinline__ float bf_lo(unsigned w) { return __builtin_bit_cast(float, w << 16); }
__device__ __forceinline__ float bf_hi(unsigned w) { return __builtin_bit_cast(float, w & 0xffff0000u); }
__device__ __forceinline__ int dpp_xor1i(int v) { return __builtin_amdgcn_update_dpp(v, v, 0xB1, 0xF, 0xF, false); }
__device__ __forceinline__ int dpp_xor2i(int v) { return __builtin_amdgcn_update_dpp(v, v, 0x4E, 0xF, 0xF, false); }
__device__ __forceinline__ int dpp_hmiri(int v) { return __builtin_amdgcn_update_dpp(v, v, 0x141, 0xF, 0xF, false); }
__device__ __forceinline__ int dpp_miri(int v)  { return __builtin_amdgcn_update_dpp(v, v, 0x140, 0xF, 0xF, false); }
__device__ __forceinline__ float dpp_xor1(float v) { return __builtin_bit_cast(float, dpp_xor1i(__builtin_bit_cast(int, v))); }
__device__ __forceinline__ float dpp_xor2(float v) { return __builtin_bit_cast(float, dpp_xor2i(__builtin_bit_cast(int, v))); }
__device__ __forceinline__ float dpp_hmir(float v) { return __builtin_bit_cast(float, dpp_hmiri(__builtin_bit_cast(int, v))); }
__device__ __forceinline__ float dpp_mir(float v)  { return __builtin_bit_cast(float, dpp_miri(__builtin_bit_cast(int, v))); }
__device__ __forceinline__ float wave_sum(float v) {
    v += dpp_xor1(v); v += dpp_xor2(v); v += dpp_hmir(v); v += dpp_mir(v);
    const int b = __builtin_bit_cast(int, v);
    const float r0 = __builtin_bit_cast(float, __builtin_amdgcn_readlane(b, 0)), r1 = __builtin_bit_cast(float, __builtin_amdgcn_readlane(b, 16)),
                r2 = __builtin_bit_cast(float, __builtin_amdgcn_readlane(b, 32)), r3 = __builtin_bit_cast(float, __builtin_amdgcn_readlane(b, 48));
    return (r0 + r1) + (r2 + r3);
}

#define XB_TMO      128
#define XB_XCNT(j)  (256  + 64 * (j))
#define XB_XSUB(j)  (1280 + 64 * (j))
#define XB_XGEN(j)  (2304 + 64 * (j))
#define XB_TOP      3328
#define XB_TOPGEN   3392
#define XCD_BAR_WORDS 3456
#define XB_SPIN_CAP (1u << 22)

__device__ __forceinline__ unsigned xb_ld(unsigned* p)              { return __hip_atomic_load(p, __ATOMIC_RELAXED, __HIP_MEMORY_SCOPE_AGENT); }
__device__ __forceinline__ unsigned xb_add(unsigned* p, unsigned v) { return __hip_atomic_fetch_add(p, v, __ATOMIC_RELAXED, __HIP_MEMORY_SCOPE_AGENT); }
__device__ __forceinline__ unsigned xb_xcc_id() { return (unsigned)__builtin_amdgcn_s_getreg((3 << 11) | 20) & 0xFu; }
#define XB_SPIN(cond, bar) do { unsigned _sp = 0; while (cond) { __builtin_amdgcn_s_sleep(1); \
    if ((++_sp & 255u) == 0u) { if (xb_ld(&(bar)[XB_TMO])) break; if (_sp > XB_SPIN_CAP) { atomicAdd(&(bar)[XB_TMO], 1u); break; } } } } while (0)

struct XcdBarrier { unsigned* bar; unsigned x; volatile LAS unsigned* st; };

__device__ __forceinline__ XcdBarrier xcd_barrier_post(unsigned* bar, volatile LAS unsigned* st) {
    XcdBarrier b; b.bar = bar; b.x = xb_xcc_id(); b.st = st;
    if (threadIdx.x == 0) (void)xb_add(&bar[XB_XCNT(b.x)], 1u);
    return b;
}
__device__ __forceinline__ void xcd_barrier_complete(unsigned* bar, unsigned x, unsigned& nloc, unsigned& nx) {
    const unsigned G = gridDim.x * gridDim.y * gridDim.z;
    unsigned sum, cnt, mine, sp = 0u;
    for (;;) {
        sum = 0u; cnt = 0u; mine = 0u;
#pragma nounroll
        for (unsigned j = 0; j < 16; ++j) { const unsigned c = xb_ld(&bar[XB_XCNT(j)]); sum += c; cnt += (c > 0u) ? 1u : 0u; mine = (j == x) ? c : mine; }
        if (sum == G) break;
        __builtin_amdgcn_s_sleep(1);
        if ((++sp & 255u) == 0u) { if (xb_ld(&bar[XB_TMO])) break; if (sp > XB_SPIN_CAP) { atomicAdd(&bar[XB_TMO], 1u); break; } }
    }
    nloc = mine > 0u ? mine : 1u; nx = cnt > 0u ? cnt : 1u;
}
__device__ __forceinline__ void xcd_barrier(const XcdBarrier& b) {
    asm volatile("s_waitcnt vmcnt(0)" ::: "memory");
    __syncthreads();
    if (threadIdx.x == 0) {
        unsigned* bar = b.bar; asm volatile("" : "+s"(bar));
        __builtin_amdgcn_s_waitcnt(0);
        unsigned nloc = b.st[0], nx = b.st[1];
        if (nloc == 0u) { xcd_barrier_complete(bar, b.x, nloc, nx); b.st[0] = nloc; b.st[1] = nx; }
        const unsigned old = xb_add(&bar[XB_XSUB(b.x)], 1u);
        const unsigned gen = old / nloc;
        if (old + 1u == (gen + 1u) * nloc) {
            __builtin_amdgcn_fence(__ATOMIC_RELEASE, "agent");
            asm volatile("s_waitcnt vmcnt(0)" ::: "memory");
            const unsigned og = xb_add(&bar[XB_TOP], 1u);
            const unsigned tg = og / nx;
            if (og + 1u == (tg + 1u) * nx) xb_add(&bar[XB_TOPGEN], 1u);
            else XB_SPIN(xb_ld(&bar[XB_TOPGEN]) == tg, bar);
            __builtin_amdgcn_fence(__ATOMIC_ACQUIRE, "agent");
            xb_add(&bar[XB_XGEN(b.x)], 1u);
            asm volatile("s_waitcnt vmcnt(0)" ::: "memory");
        } else {
            XB_SPIN(xb_ld(&bar[XB_XGEN(b.x)]) == gen, bar);
            __builtin_amdgcn_fence(__ATOMIC_ACQUIRE, "agent");
            asm volatile("s_waitcnt vmcnt(0)" ::: "memory");
        }
    }
    __syncthreads();
}
struct Frame {
    LAS unsigned char* lds;
    volatile LAS unsigned* MISC;
    gu32* ctl;
    unsigned char* ws;
    const float* in[31];
    float* X;
    int tid, lane, wave;
    int G;
    int gw, NGW;
};
enum { I_X = 0, I_C, I_ADA_W, I_ADA_B, I_NPRE, I_NPOST, I_AWIN, I_ALNG, I_ALNB, I_AWS, I_ABS, I_AWOUT, I_KVG, I_KVADAW, I_KVADAB, I_WKV, I_CPOS, I_CW1, I_CB1, I_CW2, I_CB2,
       I_BWIN, I_BWOUT, I_FG, I_FU, I_FD, I_MR, I_MRB, I_MG, I_MU, I_MD, N_IN };

struct TItem { const float* W; bf16* WT; int K, ldn, nvalid, n0, drow0, k0; float f8scale; };
__device__ __forceinline__ void p0_item_load(const TItem& t, f32x4 (&v)[8], int lane) {
    const int kr = lane >> 3, c4 = (lane & 7) * 4;
#pragma unroll
    for (int i = 0; i < 8; ++i) {
        const int kk = i * 8 + kr; const int n = t.n0 + c4;
        if (n + 3 < t.nvalid) v[i] = *(const GAS f32x4*)(t.W + (size_t)(t.k0 + kk) * t.ldn + n);
        else { const float* p = t.W + (size_t)(t.k0 + kk) * t.ldn; v[i].x = n < t.nvalid ? p[n] : 0.f; v[i].y = n + 1 < t.nvalid ? p[n + 1] : 0.f; v[i].z = n + 2 < t.nvalid ? p[n + 2] : 0.f; v[i].w = 0.f; }
    }
}
__device__ __forceinline__ void p0_item_finish(const TItem& t, const f32x4 (&v)[8], LAS float* scr, int lane) {
    const int kr = lane >> 3, c4 = (lane & 7) * 4;
#pragma unroll
    for (int i = 0; i < 8; ++i) { const int kk = i * 8 + kr; LAS float* s = scr + kk * 33 + c4; s[0] = v[i].x; s[1] = v[i].y; s[2] = v[i].z; s[3] = v[i].w; }
    LDS_WAIT(); asm volatile("" ::: "memory");
    if (t.f8scale != 0.f) {
        const int c = lane & 3; const float sc = t.f8scale;
#pragma unroll
        for (int j = 0; j < 2; ++j) { const int n = (lane >> 2) + 16 * j; const LAS float* s = scr + (16 * c) * 33 + n;
            v4u o; o.x = pg8::pk4_fp8(s[0 * 33] * sc, s[1 * 33] * sc, s[2 * 33] * sc, s[3 * 33] * sc); o.y = pg8::pk4_fp8(s[4 * 33] * sc, s[5 * 33] * sc, s[6 * 33] * sc, s[7 * 33] * sc);
            o.z = pg8::pk4_fp8(s[8 * 33] * sc, s[9 * 33] * sc, s[10 * 33] * sc, s[11 * 33] * sc); o.w = pg8::pk4_fp8(s[12 * 33] * sc, s[13 * 33] * sc, s[14 * 33] * sc, s[15 * 33] * sc);
            *(GAS v4u*)((unsigned char*)t.WT + (size_t)(t.drow0 + n) * t.K + t.k0 + 16 * c) = o; }
    } else {
        const int c = lane & 7;
#pragma unroll
        for (int j = 0; j < 4; ++j) { const int n = (lane >> 3) + 8 * j; const LAS float* s = scr + (8 * c) * 33 + n;
            v4u o; o.x = pk2(s[0 * 33], s[1 * 33]); o.y = pk2(s[2 * 33], s[3 * 33]); o.z = pk2(s[4 * 33], s[5 * 33]); o.w = pk2(s[6 * 33], s[7 * 33]);
            *(GAS v4u*)(t.WT + (size_t)(t.drow0 + n) * t.K + t.k0 + 8 * c) = o; }
    }
    LDS_WAIT(); asm volatile("" ::: "memory");
}
struct TJob { const float* src; bf16* dst; int K, ldn, nvalid, ncols, nb, map; size_t sstride, dstride; int items; float f8scale; };
__device__ __forceinline__ TJob tjob(const Frame& F, int j) {
    TJob t; unsigned char* ws = F.ws; t.map = 0; t.f8scale = 0.f;
    switch (j) {
    case 0: t.src = F.in[I_AWIN]; t.dst = (bf16*)(ws + W_AIN); t.K = 1024; t.ldn = 4096; t.ncols = 4096; t.nb = 2; break;
    case 1: t.src = F.in[I_AWOUT]; t.dst = (bf16*)(ws + W_AOUT); t.K = 2048; t.ldn = 1024; t.ncols = 1024; t.nb = 2; break;
    case 2: t.src = F.in[I_WKV]; t.dst = (bf16*)(ws + W_KV); t.K = 1024; t.ldn = 1536; t.ncols = 1536; t.nb = 1; break;
    case 3: t.src = F.in[I_CW1]; t.dst = (bf16*)(ws + W_C1); t.K = 2048; t.ldn = 256; t.ncols = 256; t.nb = 2; break;
    case 4: t.src = F.in[I_CW2]; t.dst = (bf16*)(ws + W_C2); t.K = 256; t.ldn = 64; t.ncols = 64; t.nb = 2; break;
    case 5: t.src = F.in[I_BWIN]; t.dst = (bf16*)(ws + W_BIN); t.K = 1024; t.ldn = 1072; t.ncols = NQG; t.nb = 2; break;
    case 6: t.src = F.in[I_BWOUT]; t.dst = (bf16*)(ws + W_BOUT); t.K = 1024; t.ldn = 1024; t.ncols = 1024; t.nb = 2; break;
    case 7: t.src = F.in[I_FG]; t.dst = (bf16*)(ws + W_FGU); t.K = 1024; t.ldn = DFF; t.ncols = DFF; t.nb = 2; t.map = 1; t.f8scale = FFN_F8 ? MOE_SW_GU : 0.f; break;
    case 8: t.src = F.in[I_FU]; t.dst = (bf16*)(ws + W_FGU); t.K = 1024; t.ldn = DFF; t.ncols = DFF; t.nb = 2; t.map = 2; t.f8scale = FFN_F8 ? MOE_SW_GU : 0.f; break;
    case 9: t.src = F.in[I_FD]; t.dst = (bf16*)(ws + W_FD); t.K = DFF; t.ldn = 1024; t.ncols = 1024; t.nb = 2; break;
    case 10: t.src = F.in[I_MG]; t.dst = (bf16*)(ws + W_MGU); t.K = 1024; t.ldn = DEXP; t.ncols = DEXP; t.nb = 16; t.map = 1; t.f8scale = MOE_SW_GU; break;
    case 11: t.src = F.in[I_MU]; t.dst = (bf16*)(ws + W_MGU); t.K = 1024; t.ldn = DEXP; t.ncols = DEXP; t.nb = 16; t.map = 2; t.f8scale = MOE_SW_GU; break;
    default: t.src = F.in[I_MD]; t.dst = (bf16*)(ws + W_MD); t.K = DEXP; t.ldn = 1024; t.ncols = 1024; t.nb = 16; t.f8scale = MOE_SW_D; break;
    }
    t.nvalid = t.ldn;
    t.sstride = (size_t)t.K * t.ldn; t.dstride = (size_t)t.K * (t.map ? 2 * t.ncols : t.ncols); if (t.f8scale != 0.f) t.dstride >>= 1;
    t.items = t.nb * (t.K / 64) * (t.ncols / 32);
    return t;
}
constexpr int N_TJOBS = 13;
constexpr int GEMV_CHUNKS = MODC / 256;
constexpr int GEMV_TASKS = GEMV_CHUNKS * MODKS;
__device__ __forceinline__ void p0_gemv_task(const Frame& F, int task) {
    const int cc = task / MODKS, ks = task % MODKS;
    const float* W; const float* vec; int ldn, n0, kper; bool act;
    if (cc < 96) { const int mat = cc / 12; W = F.in[I_ADA_W] + (size_t)mat * 1024 * 3072; ldn = 3072; n0 = (cc % 12) * 256; kper = 64; vec = F.in[I_C]; act = true; }
    else if (cc < 104) { W = F.in[I_KVADAW]; ldn = 2048; n0 = (cc - 96) * 256; kper = 64; vec = F.in[I_C]; act = true; }
    else { const int j = cc - 104; W = F.in[I_CW1] + (size_t)j * 2048 * 256; ldn = 256; n0 = 0; kper = 128; vec = F.in[I_CPOS] + j * 2048; act = false; }
    const int k0 = ks * kper;
    f32x4 acc = (f32x4){0.f, 0.f, 0.f, 0.f};
    const float* wp = W + (size_t)k0 * ldn + n0 + 4 * F.lane;
    for (int k = 0; k < kper; k += 8) {
        f32x4 w[8]; float a[8];
#pragma unroll
        for (int u = 0; u < 8; ++u) { w[u] = *(const GAS f32x4*)(wp + (size_t)(k + u) * ldn); a[u] = vec[k0 + k + u]; }
#pragma unroll
        for (int u = 0; u < 8; ++u) { const float av = act ? pg8::silu_f(a[u]) : a[u]; acc += w[u] * av; }
    }
    *(GAS f32x4*)((float*)(F.ws + WS_MODP) + (size_t)ks * MODC + cc * 256 + 4 * F.lane) = acc;
}
__device__ __forceinline__ void p0_prologue(Frame& F) {
    LAS float* scr = (LAS float*)(F.lds + RING_OFF + F.wave * 16384);
    for (int task = F.gw; task < GEMV_TASKS; task += F.NGW) p0_gemv_task(F, task);
    int off = 0;
    for (int j = 0; j < N_TJOBS; ++j) {
        const TJob t = tjob(F, j);
        const int nb32 = t.ncols / 32, per_b = (t.K / 64) * nb32;
        int it = (F.gw - off % F.NGW + F.NGW) % F.NGW;
#define P0_ITEM(ti_, it_) do { const int b_ = (it_) / per_b, r_ = (it_) % per_b, kb_ = r_ / nb32, nb_ = r_ % nb32, n0_ = nb_ * 32; \
            ti_.W = t.src + (size_t)b_ * t.sstride; ti_.WT = t.dst + (size_t)b_ * t.dstride; ti_.f8scale = t.f8scale; ti_.K = t.K; ti_.ldn = t.ldn; ti_.nvalid = t.nvalid; ti_.n0 = n0_; ti_.k0 = kb_ * 64; \
            ti_.drow0 = t.map ? ((n0_ >> 7) * 256 + (n0_ & 127) + (t.map == 2 ? 128 : 0)) : n0_; } while (0)
        if (it < t.items) {
            TItem cur; f32x4 vc[8]; P0_ITEM(cur, it); p0_item_load(cur, vc, F.lane);
            for (;;) {
                const int itn = it + F.NGW; const bool more = itn < t.items;
                TItem nxt = cur; f32x4 vn[8];
                if (more) { P0_ITEM(nxt, itn); p0_item_load(nxt, vn, F.lane); }
                p0_item_finish(cur, vc, scr, F.lane);
                if (!more) break;
                cur = nxt; it = itn;
#pragma unroll
                for (int i = 0; i < 8; ++i) vc[i] = vn[i];
            }
        }
#undef P0_ITEM
        off += t.items;
    }
}

__device__ __forceinline__ void moe_offsets(const Frame& F, int jm, int (&pstart)[8], int (&pend_t)[8]) {
    int acc = 0;
#pragma unroll
    for (int e = 0; e < 8; ++e) { const int c = (int)__hip_atomic_load(F.ctl + CW_MOE + jm * 1024 + 64 * e, RLX_AGENT); pstart[e] = acc; acc += (c + MOE_BLK - 1) / MOE_BLK * MOE_BLK; pend_t[e] = acc / MOE_BLK; }
#pragma unroll
    for (int e = 0; e < 8; ++e) { pstart[e] = __builtin_amdgcn_readfirstlane(pstart[e]); pend_t[e] = __builtin_amdgcn_readfirstlane(pend_t[e]); }
}
__device__ __forceinline__ float modsum(const Frame& F, int cc) {
    const float* mp = (const float*)(F.ws + WS_MODP) + cc; float s = 0.f;
#pragma unroll
    for (int k = 0; k < MODKS; ++k) s += mp[(size_t)k * MODC];
    return s;
}
template <int SRC_IN, int POST, int PRE, int KVPRE, int ROUTER, int H8 = ROUTER>
__device__ __forceinline__ void thin_phase(Frame& F, int lp, int sp, int lq, int sq, int jm_post, int jm_router) {
    LAS float* V = (LAS float*)(F.lds + RING_OFF);
    LAS float* WR = (LAS float*)(F.lds + RING_OFF + 32768);
    LAS unsigned* RS = (LAS unsigned*)(F.lds + SLC_BM_OFF);
    LAS unsigned char* H8L = F.lds + RING_OFF + 65536;
    const float* MODF = (const float*)(F.ws + WS_MOD);
#define MODV(cc_, bias_) (SRC_IN ? (modsum(F, (cc_)) + (bias_)) : MODF[(cc_)])
    if (SRC_IN) {
        for (int cc = blockIdx.x * NWAVES * 64 + F.tid; cc < 8 * 3072 + 2048; cc += F.G * NWAVES * 64)
            ((float*)(F.ws + WS_MOD))[cc] = modsum(F, cc) + (cc < 8 * 3072 ? F.in[I_ADA_B][cc] : F.in[I_KVADAB][cc - 8 * 3072]);
    }
    for (int i = F.tid; i < 1024; i += NWAVES * 64) {
        if (POST) { const int ms = lp * 2 + sp; V[0 * 1024 + i] = MODV(ms * 3072 + 2048 + i, F.in[I_ADA_B][ms * 3072 + 2048 + i]); V[1 * 1024 + i] = F.in[I_NPOST][ms * 1024 + i]; }
        if (PRE) { const int ms = lq * 2 + sq; V[2 * 1024 + i] = F.in[I_NPRE][ms * 1024 + i];
            V[3 * 1024 + i] = 1.0f + MODV(ms * 3072 + 1024 + i, F.in[I_ADA_B][ms * 3072 + 1024 + i]);
            V[4 * 1024 + i] = MODV(ms * 3072 + i, F.in[I_ADA_B][ms * 3072 + i]); }
        if (KVPRE) { V[5 * 1024 + i] = F.in[I_KVG][i]; V[6 * 1024 + i] = 1.0f + MODV(24576 + 1024 + i, F.in[I_KVADAB][1024 + i]); V[7 * 1024 + i] = MODV(24576 + i, F.in[I_KVADAB][i]); }
    }
    if (ROUTER) { for (int i = F.tid; i < 8192; i += NWAVES * 64) WR[i] = F.in[I_MR][(size_t)jm_router * 8192 + i]; if (F.tid < 16) RS[F.tid] = 0u; }
    if (SRC_IN && F.gw == 0 && !POST) {
        for (int i = F.lane; i < 512; i += 64) ((float*)(F.ws + WS_CB1))[i] = modsum(F, 26624 + i) + F.in[I_CB1][i];
    }
    __syncthreads();
    int cps[8], cpe[8]; int early_rows = 0; if (POST == 2) { moe_offsets(F, jm_post, cps, cpe); early_rows = (M3_SPLIT ? 0 : moe_early_tiles(cpe[7], F.G)) * 64; } else {
#pragma unroll
        for (int e = 0; e < 8; ++e) { cps[e] = 0; cpe[e] = 0; } }
    const float* xsrc = F.in[I_X]; bf16* X16 = (bf16*)(F.ws + WS_X16);
    const bf16* YB3 = (const bf16*)(F.ws + WS_XBUF2);
    const bf16* Yb = (const bf16*)(F.ws + WS_Y);
    const bf16* YB2 = (const bf16*)(F.ws + WS_YBUF);
    const unsigned* ROUTE = (const unsigned*)(F.ws + WS_ROUTE);
    int itn = 0;
    constexpr int PD = (POST == 2) ? 2 : 4, PY = (POST == 2) ? 1 : PD;
    f32x4 bxf[PD][4]; v2u bxh[PD][4], bya[PY][4], byb[PY][4], byc[PY][4], byd[PY][4]; unsigned rt[2][6];
#define THIN_LOAD(row_, d_) do { \
        if (SRC_IN) { _Pragma("unroll") for (int j = 0; j < 4; ++j) bxf[d_][j] = *(const GAS f32x4*)(xsrc + (size_t)(row_) * D + 4 * F.lane + 256 * j); } \
        else { _Pragma("unroll") for (int j = 0; j < 4; ++j) bxh[d_][j] = *(const GAS v2u*)(X16 + (size_t)(row_) * D + 4 * F.lane + 256 * j); } \
        if (POST == 1) { _Pragma("unroll") for (int j = 0; j < 4; ++j) bya[d_][j] = *(const GAS v2u*)(Yb + (size_t)(row_) * D + 4 * F.lane + 256 * j); } \
        } while (0)
#define THIN_ROUTE(row_, d_) do { _Pragma("unroll") for (int q_ = 0; q_ < 6; ++q_) rt[d_][q_] = ROUTE[(size_t)(row_) * 8 + q_]; } while (0)
#define THIN_YLOAD(d_) do { unsigned s1_ = rt[d_][2], s2_ = rt[d_][3]; \
        _Pragma("unroll") for (int e = 0; e < 8; ++e) { if ((int)rt[d_][0] == e) s1_ += (unsigned)cps[e]; if ((int)rt[d_][1] == e) s2_ += (unsigned)cps[e]; }     \
        const bf16* r1_ = (int)s1_ < early_rows ? YB2 : YB3; const bf16* r2_ = (int)s2_ < early_rows ? YB2 : YB3;     \
        _Pragma("unroll") for (int j = 0; j < 4; ++j) { if (M3_SPLIT) { bya[0][j] = *(const GAS v2u*)(YB2 + (size_t)s1_ * D + 4 * F.lane + 256 * j); byb[0][j] = *(const GAS v2u*)(YB2 + (size_t)s2_ * D + 4 * F.lane + 256 * j); } else { bya[0][j] = (v2u){0u, 0u}; byb[0][j] = (v2u){0u, 0u}; } \
            byc[0][j] = *(const GAS v2u*)(r1_ + (size_t)s1_ * D + 4 * F.lane + 256 * j); byd[0][j] = *(const GAS v2u*)(r2_ + (size_t)s2_ * D + 4 * F.lane + 256 * j); } } while (0)
#pragma unroll
    for (int d = 0; d < PD; ++d) {
#pragma unroll
        for (int j = 0; j < 4; ++j) { bxf[d][j] = (f32x4){0.f, 0.f, 0.f, 0.f}; bxh[d][j] = (v2u){0u, 0u}; if (d < PY) { bya[d][j] = (v2u){0u, 0u}; byb[d][j] = (v2u){0u, 0u}; byc[d][j] = (v2u){0u, 0u}; byd[d][j] = (v2u){0u, 0u}; } }
    }
#pragma unroll
    for (int q = 0; q < 6; ++q) { rt[0][q] = 0u; rt[1][q] = 0u; }
    if (POST == 2) {
        if (F.gw < M) { THIN_ROUTE(F.gw, 0); THIN_YLOAD(0); THIN_LOAD(F.gw, 0); }
        if (F.gw + F.NGW < M) THIN_ROUTE(F.gw + F.NGW, 1);
    } else {
#pragma unroll
        for (int d = 0; d < PD; ++d) if (F.gw + d * F.NGW < M) THIN_LOAD(F.gw + d * F.NGW, d);
    }
    for (int row0 = F.gw; row0 < M; row0 += PD * F.NGW) {
#pragma unroll
      for (int d = 0; d < PD; ++d) {
        const int row = row0 + d * F.NGW;
        if (row < M) {
        f32x4 x[4], y[4]; v2u ya[4];
#pragma unroll
        for (int j = 0; j < 4; ++j) { if (SRC_IN) x[j] = bxf[d][j]; else { const v2u xw_ = bxh[d][j]; x[j] = (f32x4){bf_lo(xw_.x), bf_hi(xw_.x), bf_lo(xw_.y), bf_hi(xw_.y)}; }
            ya[j] = bya[POST == 2 ? 0 : d][j]; y[j] = (f32x4){0.f, 0.f, 0.f, 0.f}; }
        if (POST == 2) {
            const float g1 = __builtin_bit_cast(float, rt[d][4]), g2 = __builtin_bit_cast(float, rt[d][5]);
#pragma unroll
            for (int j = 0; j < 4; ++j) { const v2u w = bya[0][j], z = byb[0][j], w2 = byc[0][j], z2 = byd[0][j];
                y[j] = ((f32x4){bf_lo(w.x), bf_hi(w.x), bf_lo(w.y), bf_hi(w.y)} + (f32x4){bf_lo(w2.x), bf_hi(w2.x), bf_lo(w2.y), bf_hi(w2.y)}) * g1
                     + ((f32x4){bf_lo(z.x), bf_hi(z.x), bf_lo(z.y), bf_hi(z.y)} + (f32x4){bf_lo(z2.x), bf_hi(z2.x), bf_lo(z2.y), bf_hi(z2.y)}) * g2; }
            asm volatile("" :: "v"(y[0]), "v"(y[1]), "v"(y[2]), "v"(y[3]));
            if (row + F.NGW < M) { THIN_YLOAD(d ^ 1); THIN_LOAD(row + F.NGW, d ^ 1); }
            if (row + 2 * F.NGW < M) THIN_ROUTE(row + 2 * F.NGW, d);
        } else {
            if (row + PD * F.NGW < M) THIN_LOAD(row + PD * F.NGW, d);
        }
        if (POST) {
            if (POST == 1) {
#pragma unroll
                for (int j = 0; j < 4; ++j) { const v2u w = ya[j]; y[j] = (f32x4){bf_lo(w.x), bf_hi(w.x), bf_lo(w.y), bf_hi(w.y)}; }
            }
            float ss = 0.f;
#pragma unroll
            for (int j = 0; j < 4; ++j) ss += (y[j].x * y[j].x + y[j].y * y[j].y) + (y[j].z * y[j].z + y[j].w * y[j].w);
            const float rs = 1.0f / sqrtf(wave_sum(ss) * (1.0f / D) + EPS);
#pragma unroll
            for (int j = 0; j < 4; ++j) { const f32x4 gt = *(const LAS f32x4*)(V + 0 * 1024 + 4 * F.lane + 256 * j), gp = *(const LAS f32x4*)(V + 1 * 1024 + 4 * F.lane + 256 * j);
                x[j] = x[j] + gt * (y[j] * rs * gp); }
        }
        if (POST || SRC_IN) {
            if (!PRE && !KVPRE) {
#pragma unroll
                for (int j = 0; j < 4; ++j) *(GAS f32x4*)(F.X + (size_t)row * D + 4 * F.lane + 256 * j) = x[j];
            } else {
#pragma unroll
                for (int j = 0; j < 4; ++j) { v2u w; w.x = pk2(x[j].x, x[j].y); w.y = pk2(x[j].z, x[j].w); *(GAS v2u*)(X16 + (size_t)row * D + 4 * F.lane + 256 * j) = w; }
            }
        }
        if (PRE || KVPRE) {
            float ss = 0.f;
#pragma unroll
            for (int j = 0; j < 4; ++j) ss += (x[j].x * x[j].x + x[j].y * x[j].y) + (x[j].z * x[j].z + x[j].w * x[j].w);
            const float rs = 1.0f / sqrtf(wave_sum(ss) * (1.0f / D) + EPS);
            f32x4 h[4];
            if (PRE) {
#pragma unroll
                for (int j = 0; j < 4; ++j) { const f32x4 gp = *(const LAS f32x4*)(V + 2 * 1024 + 4 * F.lane + 256 * j), sc = *(const LAS f32x4*)(V + 3 * 1024 + 4 * F.lane + 256 * j), sh = *(const LAS f32x4*)(V + 4 * 1024 + 4 * F.lane + 256 * j);
                    h[j] = (x[j] * rs * gp) * sc + sh;
                    if (H8 && ROUTER) *(LAS unsigned*)(H8L + (F.wave * 8 + itn) * 1024 + 4 * F.lane + 256 * j) = pg8::pk4_fp8(h[j].x, h[j].y, h[j].z, h[j].w);
                    else if (H8) *(GAS unsigned*)((unsigned char*)(F.ws + WS_H) + (size_t)row * D + 4 * F.lane + 256 * j) = pg8::pk4_fp8(h[j].x, h[j].y, h[j].z, h[j].w);
                    else { v2u w; w.x = pk2(h[j].x, h[j].y); w.y = pk2(h[j].z, h[j].w); *(GAS v2u*)((bf16*)(F.ws + WS_H) + (size_t)row * D + 4 * F.lane + 256 * j) = w; } }
            }
            if (KVPRE) {
#pragma unroll
                for (int j = 0; j < 4; ++j) { const f32x4 gp = *(const LAS f32x4*)(V + 5 * 1024 + 4 * F.lane + 256 * j), sc = *(const LAS f32x4*)(V + 6 * 1024 + 4 * F.lane + 256 * j), sh = *(const LAS f32x4*)(V + 7 * 1024 + 4 * F.lane + 256 * j);
                    const f32x4 hk = (x[j] * rs * gp) * sc + sh;
                    v2u w; w.x = pk2(hk.x, hk.y); w.y = pk2(hk.z, hk.w); *(GAS v2u*)((bf16*)(F.ws + WS_HKV) + (size_t)row * D + 4 * F.lane + 256 * j) = w; }
            }
            if (ROUTER) {
                float lg[8];
#pragma unroll
                for (int e = 0; e < 8; ++e) lg[e] = 0.f;
#pragma unroll
                for (int j = 0; j < 4; ++j)
#pragma unroll
                    for (int i = 0; i < 4; ++i) { const int k = 4 * F.lane + 256 * j + i; const f32x4 w0 = *(const LAS f32x4*)(WR + k * 8), w1 = *(const LAS f32x4*)(WR + k * 8 + 4); const float hv = h[j][i];
                        lg[0] += hv * w0.x; lg[1] += hv * w0.y; lg[2] += hv * w0.z; lg[3] += hv * w0.w; lg[4] += hv * w1.x; lg[5] += hv * w1.y; lg[6] += hv * w1.z; lg[7] += hv * w1.w; }
#pragma unroll
                for (int e = 0; e < 8; ++e) lg[e] = wave_sum(lg[e]) + F.in[I_MRB][jm_router * 8 + e];
                int e1 = 0; float v1 = lg[0];
#pragma unroll
                for (int e = 1; e < 8; ++e) if (lg[e] > v1) { v1 = lg[e]; e1 = e; }
                int e2 = -1; float v2 = -3.0e38f;
#pragma unroll
                for (int e = 0; e < 8; ++e) if (e != e1 && lg[e] > v2) { v2 = lg[e]; e2 = e; }
                const float ex = __expf(v2 - v1); const float rg1 = 1.0f / (1.0f + ex), rg2 = ex / (1.0f + ex);
                if (F.lane == 0) {
                    const unsigned r1 = atomicAdd((unsigned*)&RS[e1], 1u), r2 = atomicAdd((unsigned*)&RS[e2], 1u);
                    LAS unsigned* rec = RS + 16 + 8 * (F.wave * 8 + itn);
                    rec[0] = (unsigned)e1; rec[1] = (unsigned)e2; rec[2] = r1; rec[3] = r2; rec[4] = __builtin_bit_cast(unsigned, rg1); rec[5] = __builtin_bit_cast(unsigned, rg2);
                }
            }
        }
        ++itn;
        }
      }
    }
#undef THIN_LOAD
#undef THIN_ROUTE
#undef THIN_YLOAD
#undef MODV
    if (ROUTER) {
        __syncthreads();
        if (F.tid < 8) RS[8 + F.tid] = __hip_atomic_fetch_add(F.ctl + CW_MOE + jm_router * 1024 + 64 * F.tid, RS[F.tid], RLX_AGENT);
        __syncthreads();
        int it2 = 0;
        for (int row = F.gw; row < M; row += F.NGW, ++it2) {
            const LAS unsigned* rec = RS + 16 + 8 * (F.wave * 8 + it2);
            const unsigned e1 = rec[0], e2 = rec[1], p1 = RS[8 + e1] + rec[2], p2 = RS[8 + e2] + rec[3];
            const v4u hv = *(const LAS v4u*)(H8L + (F.wave * 8 + it2) * 1024 + 16 * F.lane);
            unsigned char* XB = (unsigned char*)(F.ws + WS_XBUF);
            *(GAS v4u*)(XB + ((size_t)e1 * 16384 + p1) * D + 16 * F.lane) = hv; *(GAS v4u*)(XB + ((size_t)e2 * 16384 + p2) * D + 16 * F.lane) = hv;
            if (F.lane == 0) { unsigned* o = (unsigned*)(F.ws + WS_ROUTE) + (size_t)row * 8; o[0] = e1; o[1] = e2; o[2] = p1; o[3] = p2; o[4] = rec[4]; o[5] = rec[5]; }
        }
    }
}

template <int MODE = 0> struct MoeOrderT {
    int nM, nN, G, c; int pend_t[8]; size_t estride; int ksplit; size_t khalf_bytes; int afixed;
    int early = 0;
    __device__ __forceinline__ bool next(int i, pg8::Unit& u) const {
        if (MODE == 1 && early > 0) { const int U = nM * nN, R0 = (U >> 8) - 2, Gn = 256 - early;
            if (i < R0) return pg8::tile_from_L((long)(i * 256 + c), nM, nN, u);
            if (c >= Gn) return false;
            return pg8::tile_from_L((long)(R0 * 256 + (i - R0) * Gn + c), nM, nN, u); }
        if (MODE == 2) { const int po = early >> 2; if (!pg8::tile_from_L((long)i * G + c, nM - po, nN, u)) return false; u.pm += po; return true; }
        if (MODE == 3) { const int e = c - (256 - early); if (i > 0 || e < 0) return false; u.pm = e >> 2; u.pn = e & 3; return true; }
        return pg8::tile_order(i, G, c, nM, nN, u); }
    __device__ __forceinline__ const char* a_ptr(const pg8::Gemm& g, const pg8::Unit& u) const {
        if (afixed) { int e = 0, t0 = 0;
#pragma unroll
            for (int k = 0; k < 7; ++k) { const bool ge = u.pm >= pend_t[k]; e += ge ? 1 : 0; t0 = ge ? pend_t[k] : t0; }
            return g.A + ((size_t)e * 16384 + (size_t)(u.pm - t0) * pg8::BM) * ((size_t)g.lda * 2); }
        return g.A + (size_t)u.pm * ((size_t)pg8::BM * g.lda * 2) + ((ksplit && u.pn >= (nN >> 1)) ? khalf_bytes : (size_t)0); }
    __device__ __forceinline__ const char* b_ptr(const pg8::Gemm& g, const pg8::Unit& u) const {
        int e = 0;
#pragma unroll
        for (int k = 0; k < 7; ++k) e += (u.pm >= pend_t[k]) ? 1 : 0;
        const bool hi = ksplit && u.pn >= (nN >> 1); const int pn = hi ? u.pn - (nN >> 1) : u.pn;
        return g.Bt + (size_t)e * estride + (size_t)pn * ((size_t)pg8::BM * g.ldb * 2) + (hi ? khalf_bytes : (size_t)0);
    }
};
typedef MoeOrderT<0> MoeOrder;
__device__ __forceinline__ bf16x4 tr_read(unsigned addr) { bf16x4 r; asm volatile("ds_read_b64_tr_b16 %0, %1\n\ts_waitcnt lgkmcnt(0)" : "=&v"(r) : "v"(addr) : "memory"); return r; }
__device__ __forceinline__ void spatial_phase(Frame& F, int l) {
    LAS float* stats = (LAS float*)(F.lds + RING_OFF);
    LAS float* c1 = (LAS float*)(F.lds + RING_OFF + 1024);
    LAS float* c2 = (LAS float*)(F.lds + RING_OFF + 1536);
    LAS float* bsv = (LAS float*)(F.lds + RING_OFF + 2048);
    LAS unsigned char* Wp = F.lds + RING_OFF + 4096;
    LAS unsigned char* Vt = F.lds + RING_OFF + 40960;
    LAS float* lgl = (LAS float*)(F.lds + RING_OFF + 110592);
    const bf16* Ub = (const bf16*)(F.ws + WS_U); const bf16* Vb = (const bf16*)(F.ws + WS_V); bf16* UMb = (bf16*)(F.ws + WS_UM);
    const int lane = F.lane, fr = lane & 15, fq = lane >> 4;
    for (int unit = blockIdx.x; unit < 256; unit += F.G) {
        const int c = unit >> 1, hf = unit & 1;
#pragma nounroll
        for (int ib = 0; ib < 4; ++ib) {
            v4u wv[4][4];
#pragma unroll
            for (int i = 0; i < 4; ++i) { const bf16* vr = Vb + (size_t)(c * 128 + F.wave * 16 + 4 * ib + i) * 2048;
#pragma unroll
                for (int j = 0; j < 4; ++j) wv[i][j] = *(const GAS v4u*)(vr + 8 * lane + 512 * j); }
#pragma unroll
            for (int i = 0; i < 4; ++i) {
                const int r = F.wave * 16 + 4 * ib + i; float s = 0.f, ss = 0.f;
#pragma unroll
                for (int j = 0; j < 4; ++j) { const v4u w = wv[i][j];
                    const float a0 = bf_lo(w.x), a1 = bf_hi(w.x), a2 = bf_lo(w.y), a3 = bf_hi(w.y), a4 = bf_lo(w.z), a5 = bf_hi(w.z), a6 = bf_lo(w.w), a7 = bf_hi(w.w);
                    s += ((a0 + a1) + (a2 + a3)) + ((a4 + a5) + (a6 + a7)); ss += ((a0 * a0 + a1 * a1) + (a2 * a2 + a3 * a3)) + ((a4 * a4 + a5 * a5) + (a6 * a6 + a7 * a7)); }
                s = wave_sum(s); ss = wave_sum(ss);
                const float mean = s * (1.0f / 2048.0f); float var = ss * (1.0f / 2048.0f) - mean * mean; var = var > 0.f ? var : 0.f;
                if (lane == 0) { stats[r * 2] = mean; stats[r * 2 + 1] = 1.0f / sqrtf(var + EPS); }
            }
        }
        __syncthreads();
#pragma nounroll
        for (int gi = 0; gi < 4; ++gi) {
            const int g = hf * 4 + gi;
            const float* Wg = F.in[I_AWS] + (size_t)(l * 8 + g) * 128 * 128;
            int tq = F.tid; asm volatile("" : "+v"(tq));
            v4u vtl[8], utl[8];
#pragma unroll
            for (int i = 0; i < 8; ++i) { const int p = i * 512 + tq, s = p >> 5, ch = p & 31; vtl[i] = *(const GAS v4u*)((const GAS char*)Vb + (size_t)c * 524288 + (size_t)g * 512 + (unsigned)((s * 2048 + ch * 8) * 2)); }
#pragma unroll
            for (int i = 0; i < 8; ++i) { const int p = i * 512 + tq, s = p >> 5, ch = p & 31; utl[i] = *(const GAS v4u*)((const GAS char*)Ub + (size_t)c * 524288 + (size_t)g * 512 + (unsigned)((s * 2048 + ch * 8) * 2)); }
            const float lgr = (F.tid < 256 ? F.in[I_ALNG] : F.in[I_ALNB])[l * 2048 + g * 256 + (F.tid & 255)];
            const float bsr = F.tid < 128 ? F.in[I_ABS][(l * 8 + g) * 128 + (F.tid & 127)] : 0.f;
            const float rs0 = stats[lane * 2 + 1], rs1 = stats[(lane + 64) * 2 + 1], mu0 = stats[lane * 2], mu1 = stats[(lane + 64) * 2];
#pragma nounroll
            for (int ib = 0; ib < 2; ++ib) {
            float wl[8][2];
#pragma unroll
            for (int i = 0; i < 8; ++i) { wl[i][0] = Wg[(F.wave * 16 + 8 * ib + i) * 128 + lane]; wl[i][1] = Wg[(F.wave * 16 + 8 * ib + i) * 128 + lane + 64]; }
#pragma unroll
            for (int i8 = 0; i8 < 8; ++i8) {
                const int i = i8, t = F.wave * 16 + 8 * ib + i8; float a1 = 0.f, a2 = 0.f;
#pragma unroll
                for (int h2 = 0; h2 < 2; ++h2) { const int s = lane + 64 * h2; const float w = wl[i][h2]; const float wv = s <= t ? w : 0.f; const float p = wv * (h2 ? rs1 : rs0);
                    *(LAS unsigned short*)(Wp + t * 272 + s * 2) = (unsigned short)pk2(p, 0.f); a1 += p * (h2 ? mu1 : mu0); a2 += wv; }
                a1 = wave_sum(a1); a2 = wave_sum(a2);
                if (lane == 0) { c1[t] = a1; c2[t] = a2; }
            }
            }
#pragma unroll
            for (int i = 0; i < 8; ++i) { const int p = i * 512 + tq, s = p >> 5, ch = p & 31; *(LAS v4u*)(Vt + s * 528 + ch * 16) = vtl[i]; }
            if (F.tid < 128) bsv[F.tid] = bsr;
            lgl[F.tid] = lgr;
            __syncthreads();
            f32x4 acc[2][8];
#pragma unroll
            for (int a = 0; a < 2; ++a)
#pragma unroll
                for (int b = 0; b < 8; ++b) acc[a][b] = (f32x4){0.f, 0.f, 0.f, 0.f};
            const int q = (lane & 15) >> 2, p4 = lane & 3;
#pragma unroll
            for (int dt2 = 0; dt2 < 2; ++dt2) {
                const int dt = F.wave * 2 + dt2;
#pragma unroll
                for (int ks = 0; ks < 4; ++ks) {
                    LAS unsigned char* a0 = Vt + (32 * ks + 8 * fq + q) * 528 + (16 * dt + 4 * p4) * 2;
                    const bf16x4 lo = __builtin_amdgcn_ds_read_tr16_b64_v4i16((LAS bf16x4*)a0), hi = __builtin_amdgcn_ds_read_tr16_b64_v4i16((LAS bf16x4*)(a0 + 4 * 528));
                    bf16x8 af; af[0] = lo[0]; af[1] = lo[1]; af[2] = lo[2]; af[3] = lo[3]; af[4] = hi[0]; af[5] = hi[1]; af[6] = hi[2]; af[7] = hi[3];
#pragma unroll
                    for (int tt = 2 * ks; tt < 8; ++tt) {
                        const bf16x8 bfr = *(const LAS bf16x8*)(Wp + (16 * tt + fr) * 272 + (32 * ks + 8 * fq) * 2);
                        acc[dt2][tt] = __builtin_amdgcn_mfma_f32_16x16x32_bf16(af, bfr, acc[dt2][tt], 0, 0, 0);
                    }
                }
            }
            __syncthreads();
#pragma unroll
            for (int i = 0; i < 8; ++i) { const int p = i * 512 + tq, s = p >> 5, ch = p & 31; *(LAS v4u*)(Vt + s * 528 + ch * 16) = utl[i]; }
            __syncthreads();
#pragma unroll
            for (int dt2 = 0; dt2 < 2; ++dt2) {
                const int frq = tq & 15, fqq = (tq >> 4) & 3; const int dl = 16 * (F.wave * 2 + dt2) + 4 * fqq;
                const f32x4 lg = *(const LAS f32x4*)(lgl + dl), lb = *(const LAS f32x4*)(lgl + 256 + dl);
#pragma unroll
                for (int tt = 0; tt < 8; ++tt) {
                    const int t = 16 * tt + frq;
                    const float c1t = c1[t], c2t = c2[t], bst = bsv[t];
                    LAS v2u* up = (LAS v2u*)(Vt + t * 528 + dl * 2);
                    const v2u uw = *up;
                    const f32x4 uu = (f32x4){bf_lo(uw.x), bf_hi(uw.x), bf_lo(uw.y), bf_hi(uw.y)};
                    const f32x4 mixed = lg * (acc[dt2][tt] - c1t) + lb * c2t + bst;
                    const f32x4 o = uu * mixed;
                    v2u w; w.x = pk2(o.x, o.y); w.y = pk2(o.z, o.w); *up = w;
                }
            }
            __syncthreads();
#pragma unroll
            for (int i = 0; i < 8; ++i) { const int p = i * 512 + tq, s = p >> 5, ch = p & 31;
                const v4u w = *(const LAS v4u*)(Vt + s * 528 + ch * 16); *(GAS v4u*)((GAS char*)UMb + (size_t)c * 524288 + (size_t)g * 512 + (unsigned)((s * 2048 + ch * 8) * 2)) = w; }
            __syncthreads();
        }
    }
}

struct CmpOrder {
    int G, c;
    __device__ __forceinline__ bool next(int i, pg8::Unit& u) const { const int L = i * G + c; if (L >= 32) return false; u.pm = L; u.pn = 0; return true; }
    __device__ __forceinline__ const char* a_ptr(const pg8::Gemm& g, const pg8::Unit& u) const { const int jg = u.pm >> 2, nt = u.pm & 3, j = jg >> 2, gg = jg & 3;
        return g.A + (size_t)(j * 256 + gg * 64) * 2 + (size_t)nt * ((size_t)256 * g.lda * 2); }
    __device__ __forceinline__ const char* b_ptr(const pg8::Gemm& g, const pg8::Unit& u) const { return g.Bt + (size_t)(u.pm >> 4) * ((size_t)256 * 2048 * 2); }
};
template <int PART  >
__device__ __forceinline__ void cmp2_vt_phase(Frame& F, int w0, int nw, int t_lo = 0, int t_hi = 512) {
    const int lane = F.lane, fr = lane & 15, fq = lane >> 4;
    const bf16* HID = (const bf16*)(F.ws + WS_HID);
    const bf16* KVb = (const bf16*)(F.ws + WS_KV);
    bf16* KC = (bf16*)(F.ws + WS_KCMP); bf16* VCT = (bf16*)(F.ws + WS_VCMPT); bf16* VT = (bf16*)(F.ws + WS_VT);
    LAS unsigned char* scr = F.lds + RING_OFF + F.wave * 16384;
    for (int task = (PART == 0 ? t_lo : 512) + w0; task < (PART == 0 ? t_hi : 512 + 2048 + 1024); task += nw) {
        if (task >= 512 + 2048) {
            const int tt = task - 2560, g = tt >> 8, key = (tt & 255) * 64 + lane;
#pragma unroll
            for (int br = 0; br < 2; ++br) {
                const bf16* kr = KVb + (size_t)key * 1536 + (br ? 1024 : 512) + g * 64; float ss = 0.f;
#pragma unroll
                for (int i = 0; i < 8; ++i) { const v4u kw = *(const GAS v4u*)(kr + 8 * i);
                    ss += (bf_lo(kw.x) * bf_lo(kw.x) + bf_hi(kw.x) * bf_hi(kw.x)) + (bf_lo(kw.y) * bf_lo(kw.y) + bf_hi(kw.y) * bf_hi(kw.y)) + (bf_lo(kw.z) * bf_lo(kw.z) + bf_hi(kw.z) * bf_hi(kw.z)) + (bf_lo(kw.w) * bf_lo(kw.w) + bf_hi(kw.w) * bf_hi(kw.w)); }
#pragma unroll
                for (int o = 1; o < 64; o <<= 1) ss = fmaxf(ss, shx(ss, lane, o));
                if (lane == 0) __hip_atomic_fetch_max(F.ctl + CW_KMAX + 256 * br + 64 * g, __builtin_bit_cast(unsigned, ss), RLX_AGENT);
            }
        } else if (task < 512) {
            const int rt = task, j = rt >> 8, g = (rt & 255) >> 6, n0 = (rt & 63) * 16;
            const bf16* w2t = (const bf16*)(F.ws + W_C2) + (size_t)j * 64 * 256;
            f32x4 acc[4];
#pragma unroll
            for (int dt = 0; dt < 4; ++dt) acc[dt] = (f32x4){0.f, 0.f, 0.f, 0.f};
#pragma unroll
            for (int ks = 0; ks < 8; ++ks) {
                const bf16x8 hf = *(const GAS bf16x8*)(HID + (size_t)(16 * rt + fr) * 256 + 32 * ks + 8 * fq);
#pragma unroll
                for (int dt = 0; dt < 4; ++dt) {
                    const bf16x8 wf = *(const GAS bf16x8*)(w2t + (size_t)(16 * dt + fr) * 256 + 32 * ks + 8 * fq);
                    if (j == 0) acc[dt] = __builtin_amdgcn_mfma_f32_16x16x32_bf16(wf, hf, acc[dt], 0, 0, 0);
                    else        acc[dt] = __builtin_amdgcn_mfma_f32_16x16x32_bf16(hf, wf, acc[dt], 0, 0, 0);
                }
            }
            float kss = 0.f;
#pragma unroll
            for (int dt = 0; dt < 4; ++dt) {
                if (j == 0) {
                    const int n = n0 + fr, d0 = 16 * dt + 4 * fq; const f32x4 b = *(const GAS f32x4*)(F.in[I_CB2] + d0);
                    f32x4 o = acc[dt] + b; if (n >= N_CMP) o = (f32x4){0.f, 0.f, 0.f, 0.f};
                    v2u w; w.x = pk2(o.x, o.y); w.y = pk2(o.z, o.w); *(GAS v2u*)(KC + (size_t)(g * NCMP_P + n) * 64 + d0) = w;
                    kss += (o.x * o.x + o.y * o.y) + (o.z * o.z + o.w * o.w);
                } else {
                    const int d = 16 * dt + fr, nb = n0 + 4 * fq; const float b = F.in[I_CB2][64 + d];
                    f32x4 o = acc[dt] + b;
                    if (nb + 0 >= N_CMP) o.x = 0.f; if (nb + 1 >= N_CMP) o.y = 0.f; if (nb + 2 >= N_CMP) o.z = 0.f; if (nb + 3 >= N_CMP) o.w = 0.f;
                    v2u w; w.x = pk2(o.x, o.y); w.y = pk2(o.z, o.w); *(GAS v2u*)(VCT + (size_t)(g * 64 + d) * NCMP_P + (n0 & ~31) + 8 * fq + 4 * ((n0 >> 4) & 1)) = w;
                }
            }
            if (j == 0) {
                kss += shx(kss, lane, 16); kss += shx(kss, lane, 32);
#pragma unroll
                for (int o = 1; o < 16; o <<= 1) kss = fmaxf(kss, shx(kss, lane, o));
                if (lane == 0) __hip_atomic_fetch_max(F.ctl + CW_KMAX + 512 + 64 * g, __builtin_bit_cast(unsigned, kss * 1.02f), RLX_AGENT);
            }
        } else {
            const int tt = task - 512, b = tt >> 10, g = (tt >> 8) & 3, t0 = (tt & 255) * 64;
            const int col = (b ? 1280 : 768) + g * 64;
#pragma unroll
            for (int i = 0; i < 8; ++i) { const int row = 8 * i + (lane >> 3), ch = lane & 7;
                const v4u w = *(const GAS v4u*)(KVb + (size_t)(t0 + row) * 1536 + col + ch * 8); *(LAS v4u*)(scr + row * 144 + ch * 16) = w; }
            LDS_WAIT(); asm volatile("" ::: "memory");
#pragma unroll
            for (int i = 0; i < 8; ++i) { const int dd = 8 * i + (lane >> 3), tch = lane & 7;
                unsigned short e[8];
#pragma unroll
                for (int k = 0; k < 8; ++k) e[k] = *(const LAS unsigned short*)(scr + (32 * (tch >> 2) + 16 * (k >> 2) + 4 * (tch & 3) + (k & 3)) * 144 + dd * 2);
                v4u w; w.x = e[0] | ((unsigned)e[1] << 16); w.y = e[2] | ((unsigned)e[3] << 16); w.z = e[4] | ((unsigned)e[5] << 16); w.w = e[6] | ((unsigned)e[7] << 16);
                *(GAS v4u*)(VT + ((size_t)(b * 4 + g) * 64 + dd) * M + t0 + tch * 8) = w; }
            LDS_WAIT(); asm volatile("" ::: "memory");
        }
    }
}

constexpr float LOG2E = 1.4426950408889634f;
__device__ __forceinline__ bf16x8 pack8(const f32x4& a, const f32x4& b) {
    v4u w; w.x = pg8::cvt_pk_bf16(a.x, a.y); w.y = pg8::cvt_pk_bf16(a.z, a.w); w.z = pg8::cvt_pk_bf16(b.x, b.y); w.w = pg8::cvt_pk_bf16(b.z, b.w);
    return __builtin_bit_cast(bf16x8, w);
}
struct AttSt { float l; f32x4 o[4]; };
__device__ __forceinline__ void nsa_attn_phase2(Frame& F) {
    const bf16* Qb = (const bf16*)(F.ws + WS_Q); const bf16* KVb = (const bf16*)(F.ws + WS_KV); const bf16* VT = (const bf16*)(F.ws + WS_VT);
    const bf16* KC = (const bf16*)(F.ws + WS_KCMP); const bf16* VCT = (const bf16*)(F.ws + WS_VCMPT); const float* Gt = (const float*)(F.ws + WS_G);
    bf16* Ob = (bf16*)(F.ws + WS_O);
    const int tid_o = F.tid, w = F.wave;
    LAS unsigned char* STG = F.lds + RING_OFF + 65536;
    const int xcd = blockIdx.x & 7, g = xcd & 3, par = xcd >> 2, idx = blockIdx.x >> 3;
    const int nper = F.G >> 3;
    for (int ui = 0; ui < 4; ++ui) {
        for (int rr = idx; rr < 32; rr += nper) {
        const int m_ = (ui == 0) ? rr : (ui == 1) ? 63 - rr : (ui == 2) ? 64 + rr : 127 - rr;
        const int T = 2 * m_ + par, t0 = 64 * T;
        const int nck = (4 * T + 66) >> 6, nsel = 0, nwin = T + 1 < 9 ? T + 1 : 9, total = 2 * nck + nsel + nwin;
        bf16x8 qf[2][2];
        LAS float* GL = (LAS float*)(F.lds + RING_BYTES + 2048);
        {
            int tz = tid_o; asm volatile("" : "+v"(tz));
            const int lane = tz & 63, fr = lane & 15, fq = lane >> 4, h = fr & 3;
            LAS float* imp = (LAS float*)(F.lds + RING_OFF) + w * 2048;
#pragma unroll
            for (int ct = 0; ct < 2; ++ct) { const int tc = t0 + 8 * w + 4 * ct + (fr >> 2);
                const bf16* qr = Qb + (size_t)tc * 1024 + (g * 4 + h) * 64 + 8 * fq; qf[ct][0] = *(const GAS bf16x8*)qr; qf[ct][1] = *(const GAS bf16x8*)(qr + 32);
                const GAS float* gp = (const GAS float*)Gt + (size_t)tc * 48 + (g * 4 + h) * 3; GL[tz * 6 + ct * 3 + 0] = gp[0]; GL[tz * 6 + ct * 3 + 1] = gp[1]; GL[tz * 6 + ct * 3 + 2] = gp[2]; }
#pragma unroll
            for (int i = 0; i < 8; ++i) *(LAS f32x4*)(imp + 4 * lane + 256 * i) = (f32x4){0.f, 0.f, 0.f, 0.f};
            asm volatile("" :: "v"(qf[0][0]), "v"(qf[0][1]), "v"(qf[1][0]), "v"(qf[1][1]));
        }
        float qn[2], kcm, ksm, kwm;
        {
            int tzq = tid_o; asm volatile("" : "+v"(tzq)); const int lane = tzq & 63;
            const float kcm_ = sqrtf(__builtin_bit_cast(float, __hip_atomic_load(F.ctl + CW_KMAX + 512 + 64 * g, RLX_AGENT))), ksm_ = sqrtf(__builtin_bit_cast(float, __hip_atomic_load(F.ctl + CW_KMAX + 64 * g, RLX_AGENT))),
                        kwm_ = sqrtf(__builtin_bit_cast(float, __hip_atomic_load(F.ctl + CW_KMAX + 256 + 64 * g, RLX_AGENT)));
#pragma unroll
            for (int ct = 0; ct < 2; ++ct) { float ss = 0.f;
#pragma unroll
                for (int ks = 0; ks < 2; ++ks) { const v4u qw = __builtin_bit_cast(v4u, qf[ct][ks]);
                    ss += (bf_lo(qw.x) * bf_lo(qw.x) + bf_hi(qw.x) * bf_hi(qw.x)) + (bf_lo(qw.y) * bf_lo(qw.y) + bf_hi(qw.y) * bf_hi(qw.y)) + (bf_lo(qw.z) * bf_lo(qw.z) + bf_hi(qw.z) * bf_hi(qw.z)) + (bf_lo(qw.w) * bf_lo(qw.w) + bf_hi(qw.w) * bf_hi(qw.w)); }
                ss += shx(ss, lane, 16); ss += shx(ss, lane, 32);
                qn[ct] = sqrtf(ss) * 1.01f; }
            kcm = __builtin_bit_cast(float, __builtin_amdgcn_readfirstlane(__builtin_bit_cast(int, kcm_))); ksm = __builtin_bit_cast(float, __builtin_amdgcn_readfirstlane(__builtin_bit_cast(int, ksm_))); kwm = __builtin_bit_cast(float, __builtin_amdgcn_readfirstlane(__builtin_bit_cast(int, kwm_)));
        }
        float l1[2], inv_l[2], p3prev[2]; int sel[2];
        f32x4 ofin[2][4]; AttSt st[2];
#pragma unroll
        for (int ct = 0; ct < 2; ++ct) { l1[ct] = 0.f; inv_l[ct] = 0.f; p3prev[ct] = 0.f; sel[ct] = -1; st[ct].l = 0.f;
#pragma unroll
            for (int dt = 0; dt < 4; ++dt) { ofin[ct][dt] = (f32x4){0.f, 0.f, 0.f, 0.f}; st[ct].o[dt] = (f32x4){0.f, 0.f, 0.f, 0.f}; } }
#define ATT_DMA(ci_, slot_) do { int c_ = (ci_); c_ = c_ < total ? c_ : total - 1; const int pcl_ = pc_st ^ (r_st0 & 7); const bf16* kp_; const bf16* vp_; \
            if (c_ < nck) { kp_ = KC + (size_t)(g * NCMP_P + 64 * c_ + r_st0) * 64 + pcl_ * 8; vp_ = kp_; } \
            else if (c_ < 2 * nck) { const int cc_ = c_ - nck; kp_ = KC + (size_t)(g * NCMP_P + 64 * cc_ + r_st0) * 64 + pcl_ * 8; vp_ = VCT + (size_t)(g * 64 + r_st0) * NCMP_P + 64 * cc_ + pcl_ * 8; } \
            else if (c_ < 2 * nck + nsel) { const int j_ = c_ - 2 * nck; kp_ = KVb + (size_t)(64 * j_ + r_st0) * 1536 + 512 + g * 64 + pcl_ * 8; vp_ = VT + ((size_t)(0 * 4 + g) * 64 + r_st0) * M + 64 * j_ + pcl_ * 8; } \
            else { const int k0_ = t0 - 64 * (nwin - 1) + 64 * (c_ - 2 * nck - nsel); kp_ = KVb + (size_t)(k0_ + r_st0) * 1536 + 1024 + g * 64 + pcl_ * 8; vp_ = VT + ((size_t)(1 * 4 + g) * 64 + r_st0) * M + k0_ + pcl_ * 8; } \
            __builtin_amdgcn_global_load_lds((const unsigned*)kp_, (LAS unsigned*)(STG + (slot_) * 16384 + w * 1024), 16, 0, 0); \
            __builtin_amdgcn_global_load_lds((const unsigned*)vp_, (LAS unsigned*)(STG + (slot_) * 16384 + 8192 + w * 1024), 16, 0, 0); } while (0)
        asm volatile("s_waitcnt vmcnt(0) lgkmcnt(0)" ::: "memory"); __builtin_amdgcn_s_barrier(); asm volatile("" ::: "memory");
        { int tz = tid_o; asm volatile("" : "+v"(tz)); const int r_st0 = tz >> 3, pc_st = tz & 7;
          ATT_DMA(0, 0); ATT_DMA(1, 1); ATT_DMA(2, 2); }
        int ci = 0;
        for (; ci < nck; ++ci) {
            int tz = tid_o; asm volatile("" : "+v"(tz));
            const int oz = 0, lane = tz & 63, fr = lane & 15, fq = lane >> 4, h = fr & 3, r_st0 = tz >> 3, pc_st = tz & 7;
            unsigned kro[2][2];
#pragma unroll
            for (int kt = 0; kt < 2; ++kt)
#pragma unroll
                for (int ks = 0; ks < 2; ++ks) kro[kt][ks] = (unsigned)((16 * kt + fr) * 128 + (((fq + 4 * ks) ^ (fr & 7)) << 4));
            int tcol[2];
#pragma unroll
            for (int ct = 0; ct < 2; ++ct) tcol[ct] = t0 + 8 * w + 4 * ct + (fr >> 2);
            LAS float* imp = (LAS float*)(F.lds + RING_OFF) + w * 2048;
            asm volatile("s_waitcnt vmcnt(4)" ::: "memory"); __builtin_amdgcn_s_barrier(); asm volatile("" ::: "memory");
            ATT_DMA(ci + 3, (ci + 3) & 3);
            const LAS unsigned char* kb = STG + (ci & 3) * 16384; const LAS unsigned char* vb = kb + 8192;
                const int c = ci;
#pragma nounroll
                for (int k2 = 0; k2 < 2; ++k2) {
                    bf16x8 kf[2][2];
#pragma unroll
                    for (int kt = 0; kt < 2; ++kt)
#pragma unroll
                        for (int ks = 0; ks < 2; ++ks) kf[kt][ks] = *(const LAS bf16x8*)(kb + k2 * 4096 + kro[kt][ks]);
                    {
                        f32x4 e_[2][2];
#pragma unroll
                        for (int ct = 0; ct < 2; ++ct) { const float c0_ = -(qn[ct] * kcm); const f32x4 ci_ = (f32x4){c0_, c0_, c0_, c0_};
#pragma unroll
                            for (int kt = 0; kt < 2; ++kt) e_[ct][kt] = __builtin_amdgcn_mfma_f32_16x16x32_bf16(kf[kt][0], qf[ct][0], ci_, 0, 0, 0); }
#pragma unroll
                        for (int ct = 0; ct < 2; ++ct)
#pragma unroll
                            for (int kt = 0; kt < 2; ++kt) e_[ct][kt] = __builtin_amdgcn_mfma_f32_16x16x32_bf16(kf[kt][1], qf[ct][1], e_[ct][kt], 0, 0, 0);
#pragma unroll
                        for (int ct = 0; ct < 2; ++ct)
#pragma unroll
                            for (int kt = 0; kt < 2; ++kt)
#pragma unroll
                                for (int r = 0; r < 4; ++r) e_[ct][kt][r] = __builtin_amdgcn_exp2f(e_[ct][kt][r]);
                        if (!(16 * (64 * c + 32 * k2 + 31) + 31 <= t0 + 8 * w)) {
#pragma unroll
                            for (int ct = 0; ct < 2; ++ct)
#pragma unroll
                                for (int kt = 0; kt < 2; ++kt)
#pragma unroll
                                    for (int r = 0; r < 4; ++r) { const int n = 64 * c + 32 * k2 + 16 * kt + 4 * fq + r; e_[ct][kt][r] = (16 * n + 31 <= tcol[ct]) ? e_[ct][kt][r] : 0.f; }
                        }
#pragma unroll
                        for (int ct = 0; ct < 2; ++ct) { float ls_ = l1[ct];
#pragma unroll
                            for (int kt = 0; kt < 2; ++kt)
#pragma unroll
                                for (int r = 0; r < 4; ++r) { ls_ += e_[ct][kt][r]; asm("" : "+v"(ls_)); }
                            l1[ct] = ls_; }
                    }
                }
                if (ci == nck - 1) {
#pragma unroll
                    for (int ct = 0; ct < 2; ++ct) { float lsc = l1[ct]; lsc += shx(lsc, lane, 16); lsc += shx(lsc, lane, 32); inv_l[ct] = lsc > 0.f ? -__builtin_amdgcn_logf(lsc) : -3.0e38f; }
                }
        }
        for (; ci < 2 * nck; ++ci) {
            int tz = tid_o; asm volatile("" : "+v"(tz));
            const int oz = 0, lane = tz & 63, fr = lane & 15, fq = lane >> 4, h = fr & 3, r_st0 = tz >> 3, pc_st = tz & 7;
            unsigned kro[2][2];
#pragma unroll
            for (int kt = 0; kt < 2; ++kt)
#pragma unroll
                for (int ks = 0; ks < 2; ++ks) kro[kt][ks] = (unsigned)((16 * kt + fr) * 128 + (((fq + 4 * ks) ^ (fr & 7)) << 4));
            int tcol[2];
#pragma unroll
            for (int ct = 0; ct < 2; ++ct) tcol[ct] = t0 + 8 * w + 4 * ct + (fr >> 2);
            LAS float* imp = (LAS float*)(F.lds + RING_OFF) + w * 2048;
            asm volatile("s_waitcnt vmcnt(4)" ::: "memory"); __builtin_amdgcn_s_barrier(); asm volatile("" ::: "memory");
            ATT_DMA(ci + 3, (ci + 3) & 3);
            const LAS unsigned char* kb = STG + (ci & 3) * 16384; const LAS unsigned char* vb = kb + 8192;
                const int c = ci - nck;
#pragma nounroll
                for (int k2 = 0; k2 < 2; ++k2) {
                    bf16x8 kf[2][2], vf[4];
#pragma unroll
                    for (int kt = 0; kt < 2; ++kt)
#pragma unroll
                        for (int ks = 0; ks < 2; ++ks) kf[kt][ks] = *(const LAS bf16x8*)(kb + k2 * 4096 + kro[kt][ks]);
#pragma unroll
                    for (int dt = 0; dt < 4; ++dt) { const int d = 16 * dt + fr; vf[dt] = *(const LAS bf16x8*)(vb + d * 128 + (((4 * k2 + fq) ^ (d & 7)) << 4)); }
                    {
                        f32x4 p_[2][2];
#pragma unroll
                        for (int ct = 0; ct < 2; ++ct) { const float c0_ = inv_l[ct] - qn[ct] * kcm; const f32x4 ci_ = (f32x4){c0_, c0_, c0_, c0_};
#pragma unroll
                            for (int kt = 0; kt < 2; ++kt) p_[ct][kt] = __builtin_amdgcn_mfma_f32_16x16x32_bf16(kf[kt][0], qf[ct][0], ci_, 0, 0, 0); }
#pragma unroll
                        for (int ct = 0; ct < 2; ++ct)
#pragma unroll
                            for (int kt = 0; kt < 2; ++kt) p_[ct][kt] = __builtin_amdgcn_mfma_f32_16x16x32_bf16(kf[kt][1], qf[ct][1], p_[ct][kt], 0, 0, 0);
#pragma unroll
                        for (int ct = 0; ct < 2; ++ct)
#pragma unroll
                            for (int kt = 0; kt < 2; ++kt)
#pragma unroll
                                for (int r = 0; r < 4; ++r) p_[ct][kt][r] = __builtin_amdgcn_exp2f(p_[ct][kt][r]);
                        if (!(16 * (64 * c + 32 * k2 + 31) + 31 <= t0 + 8 * w)) {
#pragma unroll
                            for (int ct = 0; ct < 2; ++ct)
#pragma unroll
                                for (int kt = 0; kt < 2; ++kt)
#pragma unroll
                                    for (int r = 0; r < 4; ++r) { const int n = 16 * (4 * c + 2 * k2 + kt) + 4 * fq + r; p_[ct][kt][r] = (16 * n + 31 <= tcol[ct]) ? p_[ct][kt][r] : 0.f; }
                        }
#pragma unroll
                        for (int ct = 0; ct < 2; ++ct) {
#pragma unroll
                            for (int kt = 0; kt < 2; ++kt) { const int nt = 4 * c + 2 * k2 + kt;
                                const float quad = ((p_[ct][kt][0] + p_[ct][kt][1]) + p_[ct][kt][2]) + p_[ct][kt][3];
                                const float rot = shl_from(p_[ct][kt][3], (lane + 48) & 63);
                                float v = quad + (fq == 0 ? p3prev[ct] : rot);
                                p3prev[ct] = rot;
                                v += dpp_xor1(v); v += dpp_xor2(v);
                                if (h == 0) imp[(ct * 4 + (fr >> 2)) * 256 + 4 * nt + fq] = v; }
                            const bf16x8 pb = pack8(p_[ct][0], p_[ct][1]);
#pragma unroll
                            for (int dt = 0; dt < 4; ++dt) st[ct].o[dt] = __builtin_amdgcn_mfma_f32_16x16x32_bf16(vf[dt], pb, st[ct].o[dt], 0, 0, 0);
                        }
                    }
                }
                if (ci == 2 * nck - 1) {
                                    asm volatile("s_waitcnt lgkmcnt(0)" ::: "memory");
                    {
                        const int tk = lane >> 4, r16 = lane & 15, jt = T;
                        float vals[2][16]; int sl[2];
#pragma unroll
                        for (int ct = 0; ct < 2; ++ct) {
#pragma unroll
                            for (int i = 0; i < 16; ++i) { const int j = r16 + 16 * i; const bool forced = (j == 0) || (j == jt) || (j == jt - 1);
                                vals[ct][i] = (j <= jt && !forced) ? imp[(ct * 4 + tk) * 256 + j] : -3.0e38f; }
                            sl[ct] = (r16 == 0) ? 0 : (r16 == 1 ? (jt >= 1 ? jt : -1) : (r16 == 2 ? (jt >= 2 ? jt - 1 : -1) : -1)); }
#define TOPK_ROUNDS(NV) do { _Pragma("nounroll") for (int rd = 3; rd < 16; ++rd) { \
                            _Pragma("unroll") for (int ct = 0; ct < 2; ++ct) { \
                                float bv = vals[ct][0]; int bi = 0; \
                                _Pragma("unroll") for (int i = 1; i < NV; ++i) if (vals[ct][i] > bv) { bv = vals[ct][i]; bi = i; } \
                                asm("" : "+v"(bi));     \
                                unsigned khi = bv >= 0.f ? __builtin_bit_cast(unsigned, bv) + 1u : 0u, klo = ~(unsigned)(r16 + 16 * bi); \
                                { unsigned ohi, olo; \
                                  ohi = (unsigned)dpp_xor1i((int)khi); olo = (unsigned)dpp_xor1i((int)klo); if ((((unsigned long long)ohi << 32) | olo) > (((unsigned long long)khi << 32) | klo)) { khi = ohi; klo = olo; } \
                                  ohi = (unsigned)dpp_xor2i((int)khi); olo = (unsigned)dpp_xor2i((int)klo); if ((((unsigned long long)ohi << 32) | olo) > (((unsigned long long)khi << 32) | klo)) { khi = ohi; klo = olo; } \
                                  ohi = (unsigned)dpp_hmiri((int)khi); olo = (unsigned)dpp_hmiri((int)klo); if ((((unsigned long long)ohi << 32) | olo) > (((unsigned long long)khi << 32) | klo)) { khi = ohi; klo = olo; } \
                                  ohi = (unsigned)dpp_miri((int)khi);  olo = (unsigned)dpp_miri((int)klo);  if ((((unsigned long long)ohi << 32) | olo) > (((unsigned long long)khi << 32) | klo)) { khi = ohi; klo = olo; } } \
                                const int bj = (int)~klo; \
                                if (r16 == rd) sl[ct] = khi != 0u ? bj : -1; \
                                _Pragma("unroll") for (int i = 0; i < NV; ++i) if ((bj & 15) == r16 && (bj >> 4) == i) vals[ct][i] = -3.0e38f; \
                            } } } while (0)
                        if (jt < 32) TOPK_ROUNDS(2); else if (jt < 64) TOPK_ROUNDS(4); else if (jt < 128) TOPK_ROUNDS(8); else if (jt < 192) TOPK_ROUNDS(12); else TOPK_ROUNDS(16);
#undef TOPK_ROUNDS
                        sel[0] = sl[0]; sel[1] = sl[1];
                    }
#pragma unroll
                    for (int ct = 0; ct < 2; ++ct) { const float gc = GL[tz * 6 + ct * 3 + 0];
#pragma unroll
                        for (int dt = 0; dt < 4; ++dt) { ofin[ct][dt] = st[ct].o[dt] * gc; st[ct].o[dt] = (f32x4){0.f, 0.f, 0.f, 0.f}; }
                        st[ct].l = 0.f;
                    }
                }
        }
        for (; ci < total; ++ci) {
            int tz = tid_o; asm volatile("" : "+v"(tz));
            const int oz = 0, lane = tz & 63, fr = lane & 15, fq = lane >> 4, h = fr & 3, r_st0 = tz >> 3, pc_st = tz & 7;
            unsigned kro[2][2];
#pragma unroll
            for (int kt = 0; kt < 2; ++kt)
#pragma unroll
                for (int ks = 0; ks < 2; ++ks) kro[kt][ks] = (unsigned)((16 * kt + fr) * 128 + (((fq + 4 * ks) ^ (fr & 7)) << 4));
            int tcol[2];
#pragma unroll
            for (int ct = 0; ct < 2; ++ct) tcol[ct] = t0 + 8 * w + 4 * ct + (fr >> 2);
            LAS float* imp = (LAS float*)(F.lds + RING_OFF) + w * 2048;
            asm volatile("s_waitcnt vmcnt(4)" ::: "memory"); __builtin_amdgcn_s_barrier(); asm volatile("" ::: "memory");
            ATT_DMA(ci + 3, (ci + 3) & 3);
            const LAS unsigned char* kb = STG + (ci & 3) * 16384; const LAS unsigned char* vb = kb + 8192;
                const int key0 = t0 - 64 * (nwin - 1) + 64 * (ci - 2 * nck);
#pragma nounroll
                for (int k2 = 0; k2 < 2; ++k2) {
                    bf16x8 kf[2][2], vf[4];
#pragma unroll
                    for (int kt = 0; kt < 2; ++kt)
#pragma unroll
                        for (int ks = 0; ks < 2; ++ks) kf[kt][ks] = *(const LAS bf16x8*)(kb + k2 * 4096 + kro[kt][ks]);
#pragma unroll
                    for (int dt = 0; dt < 4; ++dt) { const int d = 16 * dt + fr; vf[dt] = *(const LAS bf16x8*)(vb + d * 128 + (((4 * k2 + fq) ^ (d & 7)) << 4)); }
                    const int kk0 = key0 + 32 * k2;
                    {
                        f32x4 pp[2][2];
#pragma unroll
                        for (int ct = 0; ct < 2; ++ct) { const float c0_ = -(qn[ct] * kwm); const f32x4 ci_ = (f32x4){c0_, c0_, c0_, c0_};
#pragma unroll
                            for (int kt = 0; kt < 2; ++kt) pp[ct][kt] = __builtin_amdgcn_mfma_f32_16x16x32_bf16(kf[kt][0], qf[ct][0], ci_, 0, 0, 0); }
#pragma unroll
                        for (int ct = 0; ct < 2; ++ct)
#pragma unroll
                            for (int kt = 0; kt < 2; ++kt) pp[ct][kt] = __builtin_amdgcn_mfma_f32_16x16x32_bf16(kf[kt][1], qf[ct][1], pp[ct][kt], 0, 0, 0);
#pragma unroll
                        for (int ct = 0; ct < 2; ++ct)
#pragma unroll
                            for (int kt = 0; kt < 2; ++kt)
#pragma unroll
                                for (int r = 0; r < 4; ++r) pp[ct][kt][r] = __builtin_amdgcn_exp2f(pp[ct][kt][r]);
                        if (!((kk0 + 31 <= t0 + 8 * w) && (kk0 > t0 + 8 * w + 7 - 512))) {
#pragma unroll
                            for (int ct = 0; ct < 2; ++ct)
#pragma unroll
                                for (int kt = 0; kt < 2; ++kt)
#pragma unroll
                                    for (int r = 0; r < 4; ++r) { const int key = kk0 + 16 * kt + 4 * fq + r; pp[ct][kt][r] = (key <= tcol[ct] && key > tcol[ct] - 512) ? pp[ct][kt][r] : 0.f; }
                        }
#pragma unroll
                        for (int ct = 0; ct < 2; ++ct) {
                            { float ls_ = st[ct].l;
#pragma unroll
                              for (int kt = 0; kt < 2; ++kt)
#pragma unroll
                                  for (int r = 0; r < 4; ++r) { ls_ += pp[ct][kt][r]; asm("" : "+v"(ls_)); }
                              st[ct].l = ls_; }
                            const bf16x8 pb = pack8(pp[ct][0], pp[ct][1]);
#pragma unroll
                            for (int dt = 0; dt < 4; ++dt) st[ct].o[dt] = __builtin_amdgcn_mfma_f32_16x16x32_bf16(vf[dt], pb, st[ct].o[dt], 0, 0, 0);
                        }
                    }
                }
                if (ci == total - 1) {
#pragma unroll
                    for (int ct = 0; ct < 2; ++ct) {
                        float ls = st[ct].l; ls += shx(ls, lane, 16); ls += shx(ls, lane, 32);
                        const float gg = GL[tz * 6 + ct * 3 + 2] * __builtin_amdgcn_rcpf(ls);
#pragma unroll
                        for (int dt = 0; dt < 4; ++dt) { ofin[ct][dt] = ofin[ct][dt] + st[ct].o[dt] * gg; st[ct].o[dt] = (f32x4){0.f, 0.f, 0.f, 0.f}; }
                        st[ct].l = 0.f;
                    }
                }
        }
        {
            int tz = tid_o; asm volatile("" : "+v"(tz));
            const int lane = tz & 63, fr = lane & 15, fq = lane >> 4, h = fr & 3, r_st0 = tz >> 3, pc_st = tz & 7;
#pragma unroll
            for (int ct = 0; ct < 2; ++ct) { st[ct].l = 0.f;
#pragma unroll
                for (int dt = 0; dt < 4; ++dt) st[ct].o[dt] = (f32x4){0.f, 0.f, 0.f, 0.f}; }
            const int nwnd = (T + 4) >> 2;
            LAS unsigned char* HB = F.lds + RING_OFF;
#define SLC_DMA(k_, half_) do { const int pcl_ = pc_st ^ (r_st0 & 7); _Pragma("unroll") for (int b_ = 0; b_ < 4; ++b_) { int j_ = 4 * (k_) + b_; j_ = j_ < T ? j_ : T; \
                const bf16* kp_ = KVb + (size_t)(64 * j_ + r_st0) * 1536 + 512 + g * 64 + pcl_ * 8; const bf16* vp_ = VT + ((size_t)g * 64 + r_st0) * M + 64 * j_ + pcl_ * 8; \
                __builtin_amdgcn_global_load_lds((const unsigned*)kp_, (LAS unsigned*)(HB + (half_) * 65536 + b_ * 16384 + w * 1024), 16, 0, 0); \
                __builtin_amdgcn_global_load_lds((const unsigned*)vp_, (LAS unsigned*)(HB + (half_) * 65536 + b_ * 16384 + 8192 + w * 1024), 16, 0, 0); } } while (0)
#ifndef MK_PROBE_A
#define MK_PROBE_A 0
#endif
            for (int ppass_ = 0; ppass_ < (MK_PROBE_A == 1 ? 2 : 1); ++ppass_) {
            asm volatile("s_waitcnt vmcnt(0) lgkmcnt(0)" ::: "memory"); __builtin_amdgcn_s_barrier(); asm volatile("" ::: "memory");
            { int tz3 = tid_o; asm volatile("" : "+v"(tz3)); const int r_st0 = tz3 >> 3, pc_st = tz3 & 7; SLC_DMA(0, 0); }
            for (int k = 0; k < nwnd; ++k) {
                int tz2 = tid_o; asm volatile("" : "+v"(tz2));
                const int lane = tz2 & 63, fr = lane & 15, fq = lane >> 4, r_st0 = tz2 >> 3, pc_st = tz2 & 7;
                asm volatile("s_waitcnt vmcnt(0)" ::: "memory"); __builtin_amdgcn_s_barrier(); asm volatile("" ::: "memory");
                if (k + 1 < nwnd) SLC_DMA(k + 1, (k + 1) & 1);
#pragma nounroll
                for (int b = 0; b < 4; ++b) {
                    const int j = 4 * k + b;
                    bool act[2], cs[2];
#pragma unroll
                    for (int ct = 0; ct < 2; ++ct) { const unsigned long long mk = __ballot(sel[ct] == j); act[ct] = mk != 0ull; cs[ct] = ((mk >> (16 * (fr >> 2))) & 0xFFFFull) != 0ull; }
                    if (!(act[0] || act[1])) continue;
                    const LAS unsigned char* kb = HB + (k & 1) * 65536 + b * 16384; const LAS unsigned char* vb = kb + 8192;
                    bf16x8 kf[4][2], vf[4][2];
#pragma unroll
                    for (int kt = 0; kt < 4; ++kt)
#pragma unroll
                        for (int ks = 0; ks < 2; ++ks) kf[kt][ks] = *(const LAS bf16x8*)(kb + (16 * kt + fr) * 128 + (((fq + 4 * ks) ^ (fr & 7)) << 4));
#pragma unroll
                    for (int dt = 0; dt < 4; ++dt)
#pragma unroll
                        for (int k2 = 0; k2 < 2; ++k2) { const int d = 16 * dt + fr; vf[dt][k2] = *(const LAS bf16x8*)(vb + d * 128 + (((4 * k2 + fq) ^ (d & 7)) << 4)); }
#pragma unroll
                    for (int ct = 0; ct < 2; ++ct) if (act[ct]) {
                        const int tc = t0 + 8 * w + 4 * ct + (fr >> 2);
                        const float mre = cs[ct] ? qn[ct] * ksm : 3.0e38f;
                        {
                            f32x4 pp[4]; const f32x4 ci_ = (f32x4){-mre, -mre, -mre, -mre};
#pragma unroll
                            for (int kt = 0; kt < 4; ++kt) pp[kt] = __builtin_amdgcn_mfma_f32_16x16x32_bf16(kf[kt][0], qf[ct][0], ci_, 0, 0, 0);
#pragma unroll
                            for (int kt = 0; kt < 4; ++kt) pp[kt] = __builtin_amdgcn_mfma_f32_16x16x32_bf16(kf[kt][1], qf[ct][1], pp[kt], 0, 0, 0);
#pragma unroll
                            for (int kt = 0; kt < 4; ++kt)
#pragma unroll
                                for (int r = 0; r < 4; ++r) pp[kt][r] = __builtin_amdgcn_exp2f(pp[kt][r]);
                            if (j == T) {
#pragma unroll
                                for (int kt = 0; kt < 4; ++kt)
#pragma unroll
                                    for (int r = 0; r < 4; ++r) { const int key = 64 * j + 16 * kt + 4 * fq + r; pp[kt][r] = key <= tc ? pp[kt][r] : 0.f; }
                            }
                            const bf16x8 pb0 = pack8(pp[0], pp[1]), pb1 = pack8(pp[2], pp[3]);
                            { float ls_ = st[ct].l;
#pragma unroll
                              for (int kt = 0; kt < 4; ++kt)
#pragma unroll
                                  for (int r = 0; r < 4; ++r) { ls_ += pp[kt][r]; asm("" : "+v"(ls_)); }
                              st[ct].l = ls_; }
#pragma unroll
                            for (int dt = 0; dt < 4; ++dt) st[ct].o[dt] = __builtin_amdgcn_mfma_f32_16x16x32_bf16(vf[dt][0], pb0, st[ct].o[dt], 0, 0, 0);
#pragma unroll
                            for (int dt = 0; dt < 4; ++dt) st[ct].o[dt] = __builtin_amdgcn_mfma_f32_16x16x32_bf16(vf[dt][1], pb1, st[ct].o[dt], 0, 0, 0);
                        }
                    }
                }
            }
            }
#undef SLC_DMA
            asm volatile("s_waitcnt lgkmcnt(0)" ::: "memory"); __builtin_amdgcn_s_barrier(); asm volatile("" ::: "memory");
#pragma unroll
            for (int ct = 0; ct < 2; ++ct) {
                float ls = st[ct].l; ls += shx(ls, lane, 16); ls += shx(ls, lane, 32);
                const float gg = GL[tz * 6 + ct * 3 + 1] * __builtin_amdgcn_rcpf(ls);
#pragma unroll
                for (int dt = 0; dt < 4; ++dt) { const f32x4 o = ofin[ct][dt] + st[ct].o[dt] * gg; v2u wv; wv.x = pk2(o.x, o.y); wv.y = pk2(o.z, o.w);
                    *(LAS v2u*)(F.lds + RING_OFF + w * 8192 + ((4 * ct + (fr >> 2)) * 4 + h) * 144 + dt * 32 + fq * 8) = wv; }
            }
#pragma unroll
            for (int i = 0; i < 4; ++i) { const int P = i * 64 + lane, tl = P >> 5, q = P & 31;
                const v4u wv = *(const LAS v4u*)(F.lds + RING_OFF + w * 8192 + (tl * 4 + (q >> 3)) * 144 + (q & 7) * 16);
                *(GAS v4u*)(Ob + (size_t)(t0 + 8 * w + tl) * 1024 + g * 256 + q * 8) = wv; }
        }
#undef ATT_DMA
        }
    }
}
#ifndef MK_PER_PHASE
#define MK_PER_PHASE 0
#endif
#ifndef MK_STOP_LAYERS
#define MK_STOP_LAYERS 4
#endif
#ifndef MK_MASK
#define MK_MASK 0xFFFFFFFFu
#endif
#define EN(b) ((MK_MASK >> (b)) & 1u)
#ifndef MK_REPEAT
#define MK_REPEAT 0u
#endif
#define REP(b) ((MK_REPEAT >> (b)) & 1u)
constexpr int SLOTS = 11, NPH = 2 + DEPTH * SLOTS;
struct Args { const float* in[N_IN]; float* out; unsigned char* ws; int ph_lo, ph_hi; };
__host__ __device__ inline bool phase_exists(int pid) {
    if (pid < 2) return true;
    const int layer = (pid - 2) / SLOTS, slot = (pid - 2) % SLOTS;
    if (layer >= MK_STOP_LAYERS) return false;
    if (slot <= 2) return layer == 2;
    if (slot == 3) return layer != 2;
    if (slot == 7) return false;
    return true;
}
__global__ void __launch_bounds__(NWAVES * 64, 2) fwd_kernel(Args args) {
    extern __shared__ __attribute__((aligned(16))) unsigned char lds[];
    Frame F;
    F.lds = (LAS unsigned char*)lds;
    F.MISC = (volatile LAS unsigned*)(F.lds + MISC_OFF);
    F.tid = threadIdx.x; F.lane = F.tid & 63; F.wave = __builtin_amdgcn_readfirstlane(F.tid >> 6);
    F.G = gridDim.x; F.gw = blockIdx.x * NWAVES + F.wave; F.NGW = F.G * NWAVES;
    F.ws = args.ws; F.ctl = (gu32*)(args.ws + WS_CTL); F.X = args.out;
#pragma unroll
    for (int i = 0; i < N_IN; ++i) F.in[i] = args.in[i];
    for (int u = F.tid; u < (LDS_BYTES - LDSCTL_OFF) / 4; u += NWAVES * 64) ((LAS unsigned*)(F.lds + LDSCTL_OFF))[u] = 0u;
    __syncthreads();
    XcdBarrier bar; bar.bar = (unsigned*)(F.ctl + CW_BAR); bar.x = 0; bar.st = nullptr;
    if (!MK_PER_PHASE) bar = xcd_barrier_post((unsigned*)(F.ctl + CW_BAR), F.MISC + 8);
    const int lo = args.ph_lo, hi = args.ph_hi;
#define IN(k) (lo <= (k) && (k) < hi)
#define PHASE_BEGIN() Frame P = F; { unsigned on_ = ~0u; asm volatile("" : "+s"(on_)); int t_ = F.wave * 64 + (int)__builtin_amdgcn_mbcnt_hi(on_, __builtin_amdgcn_mbcnt_lo(on_, 0u));   asm volatile("" : "+v"(t_)); unsigned char* w_ = args.ws; asm volatile("" : "+s"(w_)); P.tid = t_; P.lane = t_ & 63; P.wave = __builtin_amdgcn_readfirstlane(t_ >> 6); P.gw = blockIdx.x * NWAVES + P.wave; P.ws = w_; P.ctl = (gu32*)(w_ + WS_CTL); } unsigned char* ws = P.ws; LAS unsigned char* ring = P.lds + RING_OFF; const int ptid = P.tid; (void)ws; (void)ring; (void)ptid
#ifndef MK_DOUBLE_BAR
#define MK_DOUBLE_BAR 0
#endif
#define SEAM(k) do { if (!MK_PER_PHASE && (k) + 1 < hi) { xcd_barrier(bar); if (MK_DOUBLE_BAR) xcd_barrier(bar); } } while (0)

    if (EN(0) && IN(0)) for (int rep_ = 0; rep_ < 1 + (int)REP(0); ++rep_) { PHASE_BEGIN(); p0_prologue(P); SEAM(0); }
    if (EN(1) && IN(1)) for (int rep_ = 0; rep_ < 1 + (int)REP(1); ++rep_) { PHASE_BEGIN(); thin_phase<1, 0, 1, 0, 0>(P, 0, 0, 0, 0, 0, 0); SEAM(1); }

    for (int layer = 0; layer < MK_STOP_LAYERS; ++layer) {
        const int base = 2 + layer * SLOTS;
        const int j2 = layer >> 1;
        if (layer < 2) {
            if (EN(2) && IN(base + 3)) for (int rep_ = 0; rep_ < 1 + (int)REP(2); ++rep_) { PHASE_BEGIN();
                pg8::Gemm g{(const char*)(ws + WS_H), (const char*)(ws + W_AIN) + (size_t)layer * 4096 * 1024 * 2, 1024, 1024u, 1024u, 128u};
                pg8::StaticOrder S; S.init(M, 4096, F.G, (int)blockIdx.x);
                pg8::EpiBf16<1> E{(bf16*)(ws + WS_U), 2048, nullptr, 2048, (size_t)(WS_V - WS_U) / 2, 1.0f, -1, 0};
                pg8::gemm_phase<pg8::EpiBf16<1>, pg8::StaticOrder>(ptid, ring, g, S, E);
                SEAM(base + 3);
            }
            if (EN(3) && IN(base + 4)) for (int rep_ = 0; rep_ < 1 + (int)REP(3); ++rep_) { PHASE_BEGIN(); spatial_phase(P, layer); SEAM(base + 4); }
            if (EN(4) && IN(base + 5)) for (int rep_ = 0; rep_ < 1 + (int)REP(4); ++rep_) { PHASE_BEGIN();
                pg8::Gemm g{(const char*)(ws + WS_UM), (const char*)(ws + W_AOUT) + (size_t)layer * 1024 * 2048 * 2, 2048, 2048u, 2048u, 128u};
                pg8::StaticOrder S; S.init(M, 1024, F.G, (int)blockIdx.x);
                pg8::EpiBf16<0> E{(bf16*)(ws + WS_Y), 1024, nullptr, 0, 0, 1.0f, -1, 0};
                pg8::gemm_phase<pg8::EpiBf16<0>, pg8::StaticOrder>(ptid, ring, g, S, E);
                SEAM(base + 5);
            }
        } else {
            const int li = layer - 2;
            if (layer == 2) {
                if (EN(5) && IN(base + 0)) for (int rep_ = 0; rep_ < 1 + (int)REP(5); ++rep_) { PHASE_BEGIN();
                    pg8::Gemm g{(const char*)(ws + WS_HKV), (const char*)(ws + W_KV), 1024, 1024u, 1024u, 128u};
                    pg8::StaticOrder S; S.init(M, 1536, F.G, (int)blockIdx.x);
                    pg8::EpiBf16<0> E{(bf16*)(ws + WS_KV), 1536, nullptr, 0, 0, 1.0f, -1, 0};
                    pg8::gemm_phase<pg8::EpiBf16<0>, pg8::StaticOrder>(ptid, ring, g, S, E);
                    pg8::Gemm g2{(const char*)(ws + WS_H), (const char*)(ws + W_BIN), 1024, 1024u, 1024u, 128u};
                    pg8::StaticOrder S2; S2.init(M, NQG, F.G, (int)(F.G - 1 - blockIdx.x));
                    pg8::EpiQG E2{(bf16*)(ws + WS_Q), (float*)(ws + WS_G), 0.125f * 1.4426950408889634f};
                    pg8::gemm_phase<pg8::EpiQG, pg8::StaticOrder>(ptid, ring, g2, S2, E2);
                    SEAM(base + 0);
                }
                if (EN(6) && IN(base + 1)) for (int rep_ = 0; rep_ < 1 + (int)REP(6); ++rep_) { PHASE_BEGIN();
                    pg8::Gemm g{(const char*)(ws + WS_KV), (const char*)(ws + W_C1), 2048, 16u * 1536u, 2048u, 1536u * 2u};
                    CmpOrder S{F.G, (int)blockIdx.x};
                    pg8::EpiBf16<1> E{(bf16*)(ws + WS_HID), 256, (const float*)(ws + WS_CB1), 0, 0, 1.0f, 4, 256};
                    pg8::gemm_phase<pg8::EpiBf16<1>, CmpOrder>(ptid, ring, g, S, E);
                    if (blockIdx.x >= 32) cmp2_vt_phase<1>(P, (int)(blockIdx.x - 32) * NWAVES + P.wave, (int)(F.G - 32) * NWAVES);
                    SEAM(base + 1);
                }
                if (EN(7) && IN(base + 2)) for (int rep_ = 0; rep_ < 1 + (int)REP(7); ++rep_) { PHASE_BEGIN(); cmp2_vt_phase<0>(P, P.gw, P.NGW); SEAM(base + 2); }
            }
            if (layer == 3 && EN(8) && IN(base + 3)) for (int rep_ = 0; rep_ < 1 + (int)REP(8); ++rep_) { PHASE_BEGIN();
                pg8::Gemm g{(const char*)(ws + WS_H), (const char*)(ws + W_BIN) + (size_t)li * NQG * 1024 * 2, 1024, 1024u, 1024u, 128u};
                pg8::StaticOrder S; S.init(M, NQG, F.G, (int)blockIdx.x);
                pg8::EpiQG E{(bf16*)(ws + WS_Q), (float*)(ws + WS_G), 0.125f * 1.4426950408889634f};
                pg8::gemm_phase<pg8::EpiQG, pg8::StaticOrder>(ptid, ring, g, S, E);
                SEAM(base + 3);
            }
            if (EN(9) && IN(base + 4)) for (int rep_ = 0; rep_ < 1 + (int)REP(9); ++rep_) { PHASE_BEGIN(); nsa_attn_phase2(P); SEAM(base + 4); }
            if (EN(10) && IN(base + 5)) for (int rep_ = 0; rep_ < 1 + (int)REP(10); ++rep_) { PHASE_BEGIN();
                pg8::Gemm g{(const char*)(ws + WS_O), (const char*)(ws + W_BOUT) + (size_t)li * 1024 * 1024 * 2, 1024, 1024u, 1024u, 128u};
                pg8::StaticOrder S; S.init(M, 1024, F.G, (int)blockIdx.x);
                pg8::EpiBf16<0> E{(bf16*)(ws + WS_Y), 1024, nullptr, 0, 0, 1.0f, -1, 0};
                pg8::gemm_phase<pg8::EpiBf16<0>, pg8::StaticOrder>(ptid, ring, g, S, E);
                SEAM(base + 5);
            }
        }
        if (EN(11) && IN(base + 6)) for (int rep_ = 0; rep_ < 1 + (int)REP(11); ++rep_) { PHASE_BEGIN();
            if (layer & 1) thin_phase<0, 1, 1, 0, 1>(P, layer, 0, layer, 1, 0, j2);
            else           thin_phase<0, 1, 1, 0, 0, FFN_F8>(P, layer, 0, layer, 1, 0, 0);
            SEAM(base + 6);
        }
        if ((layer & 1) == 0) {
            if (EN(12) && IN(base + 8)) for (int rep_ = 0; rep_ < 1 + (int)REP(12); ++rep_) { PHASE_BEGIN();
                pg8::StaticOrder S; S.init(M, 5632, F.G, (int)blockIdx.x);
#if FFN_F8
                pg8::Gemm g{(const char*)(ws + WS_H), (const char*)(ws + W_FGU) + (size_t)j2 * 5632 * 1024, 512, 512u, 512u, 128u};
                pg8::EpiSwigluS E{(bf16*)(ws + WS_ACT), DFF, 1.0f / MOE_SW_GU};
                pg8::gemm_phase<pg8::EpiSwigluS, pg8::StaticOrder, true, true>(ptid, ring, g, S, E);
#else
                pg8::Gemm g{(const char*)(ws + WS_H), (const char*)(ws + W_FGU) + (size_t)j2 * 5632 * 1024 * 2, 1024, 1024u, 1024u, 128u};
                pg8::EpiSwiglu E{(bf16*)(ws + WS_ACT), DFF};
                pg8::gemm_phase<pg8::EpiSwiglu, pg8::StaticOrder>(ptid, ring, g, S, E);
#endif
                SEAM(base + 8);
            }
            if (EN(13) && IN(base + 9)) for (int rep_ = 0; rep_ < 1 + (int)REP(13); ++rep_) { PHASE_BEGIN();
                pg8::Gemm g{(const char*)(ws + WS_ACT), (const char*)(ws + W_FD) + (size_t)j2 * 1024 * DFF * 2, DFF, (unsigned)DFF, (unsigned)DFF, 128u};
                pg8::StaticOrder S; S.init(M, 1024, F.G, (int)blockIdx.x);
                pg8::EpiBf16<0> E{(bf16*)(ws + WS_Y), 1024, nullptr, 0, 0, 1.0f, -1, 0};
                pg8::gemm_phase<pg8::EpiBf16<0>, pg8::StaticOrder>(ptid, ring, g, S, E);
                SEAM(base + 9);
            }
        } else {
            if (EN(15) && IN(base + 8)) for (int rep_ = 0; rep_ < 1 + (int)REP(15); ++rep_) { PHASE_BEGIN();
                int pstart[8]; MoeOrderT<1> S; moe_offsets(P, j2, pstart, S.pend_t);
                S.nM = S.pend_t[7]; S.nN = 28; S.G = F.G; S.c = (int)blockIdx.x; S.estride = (size_t)7168 * 1024; S.ksplit = 0; S.khalf_bytes = 0; S.afixed = 1;
                const int early = M3_SPLIT ? 0 : moe_early_tiles(S.nM, F.G); S.early = early;
                unsigned* ecnt = (unsigned*)(P.ctl + CW_EARLY + 64 * j2);
                pg8::Gemm g{(const char*)(ws + WS_XBUF), (const char*)(ws + W_MGU) + (size_t)j2 * 8 * 7168 * 1024, 512, 512u, 512u, 128u};
                pg8::EpiSwigluF8 E{(unsigned char*)(ws + WS_ACTM), DEXP, 1.0f / MOE_SW_GU, MOE_SA, ecnt, early >> 2};
                pg8::gemm_phase<pg8::EpiSwigluF8, MoeOrderT<1>, true, true>(ptid, ring, g, S, E);
            }
            if (EN(15) && IN(base + 8)) { PHASE_BEGIN();
                int pstart[8]; MoeOrderT<1> S; moe_offsets(P, j2, pstart, S.pend_t);
                S.nM = S.pend_t[7]; S.G = F.G; S.c = (int)blockIdx.x;
                const int early = M3_SPLIT ? 0 : moe_early_tiles(S.nM, F.G);
                unsigned* ecnt = (unsigned*)(P.ctl + CW_EARLY + 64 * j2);
                if (early > 0 && (int)blockIdx.x >= F.G - early) {
                    const int pm_e = ((int)blockIdx.x - (F.G - early)) >> 2;
                    if (ptid == 0) { unsigned sp_ = 0u; while (__hip_atomic_load(ecnt + pm_e, __ATOMIC_RELAXED, __HIP_MEMORY_SCOPE_AGENT) < 28u * 8u * (1u + REP(15) * 0u) && ++sp_ < 40000000u) __builtin_amdgcn_s_sleep(2);
                        __builtin_amdgcn_fence(__ATOMIC_ACQUIRE, "agent"); }
                    __syncthreads();
                    MoeOrderT<3> S3; S3.nM = S.nM; S3.G = S.G; S3.c = S.c; S3.early = early; S3.ksplit = 0; S3.khalf_bytes = 0;
#pragma unroll
                    for (int e_ = 0; e_ < 8; ++e_) S3.pend_t[e_] = S.pend_t[e_];
                    S3.nN = 4; S3.estride = (size_t)1024 * DEXP; S3.afixed = 0;
                    pg8::Gemm g3{(const char*)(ws + WS_ACTM), (const char*)(ws + W_MD) + (size_t)j2 * 8 * 1024 * DEXP, DEXP / 2, (unsigned)DEXP / 2u, (unsigned)DEXP / 2u, 128u};
                    pg8::EpiBf16<0> E3{(bf16*)(ws + WS_YBUF), 1024, nullptr, 0, 0, 1.0f / (MOE_SW_D * MOE_SA), -1, 0};
                    int ptid3 = ptid; asm volatile("" : "+v"(ptid3));
                    pg8::gemm_phase<pg8::EpiBf16<0>, MoeOrderT<3>, true, true>(ptid3, ring, g3, S3, E3);
                }
                SEAM(base + 8);
            }
            if (EN(16) && IN(base + 9)) for (int rep_ = 0; rep_ < 1 + (int)REP(16); ++rep_) { PHASE_BEGIN();
                int pstart[8]; MoeOrderT<2> S; moe_offsets(P, j2, pstart, S.pend_t);
                S.nM = S.pend_t[7]; S.nN = M3_SPLIT ? 8 : 4; S.G = F.G; S.c = (int)blockIdx.x; S.estride = (size_t)1024 * DEXP; S.ksplit = M3_SPLIT; S.khalf_bytes = (size_t)(DEXP / 2); S.afixed = 0;
                S.early = M3_SPLIT ? 0 : moe_early_tiles(S.nM, F.G);
                pg8::Gemm g{(const char*)(ws + WS_ACTM), (const char*)(ws + W_MD) + (size_t)j2 * 8 * 1024 * DEXP, M3_SPLIT ? DEXP / 4 : DEXP / 2, (unsigned)DEXP / 2u, (unsigned)DEXP / 2u, 128u};
                pg8::EpiBf16<0> E{(bf16*)(ws + WS_XBUF2), 1024, nullptr, M3_SPLIT ? 1024 : 0, (size_t)(WS_YBUF - WS_XBUF2) / 2, 1.0f / (MOE_SW_D * MOE_SA), -1, 0};
                pg8::gemm_phase<pg8::EpiBf16<0>, MoeOrderT<2>, true, true>(ptid, ring, g, S, E);
                SEAM(base + 9);
            }
        }
        if (EN(17) && IN(base + 10)) for (int rep_ = 0; rep_ < 1 + (int)REP(17); ++rep_) { PHASE_BEGIN();
            if (layer == 0)      thin_phase<0, 1, 1, 0, 0>(P, 0, 1, 1, 0, 0, 0);
            else if (layer == 1) thin_phase<0, 2, 1, 1, 0>(P, 1, 1, 2, 0, 0, 0);
            else if (layer == 2) thin_phase<0, 1, 1, 0, 0>(P, 2, 1, 3, 0, 0, 0);
            else                 thin_phase<0, 2, 0, 0, 0>(P, 3, 1, 0, 0, 1, 0);
            SEAM(base + 10);
        }
    }
#undef IN
#undef SEAM
}

extern "C" void kernel_launch(void* const* d_in, const int* in_sizes, int n_in, void* d_out, int out_size, void* d_ws, size_t ws_size, hipStream_t stream) {
    static int grid = 0;
    if (grid == 0) {
        if (n_in != N_IN || in_sizes[0] != M * D || out_size != M * D || ws_size < WS_END) {
            fprintf(stderr, "kernel_launch: unexpected problem: n_in %d in0 %d out %d ws %zu (need %zu)\n", n_in, n_in > 0 ? in_sizes[0] : -1, out_size, ws_size, (size_t)WS_END); grid = -1; return; }
        int dev = 0, cus = 0, per_cu = 0;
        if (hipGetDevice(&dev) != hipSuccess || hipDeviceGetAttribute(&cus, hipDeviceAttributeMultiprocessorCount, dev) != hipSuccess) { grid = -1; return; }
        if (hipFuncSetAttribute((const void*)fwd_kernel, hipFuncAttributeMaxDynamicSharedMemorySize, LDS_BYTES) != hipSuccess) { fprintf(stderr, "kernel_launch: hipFuncSetAttribute failed\n"); grid = -1; return; }
        if (hipOccupancyMaxActiveBlocksPerMultiprocessor(&per_cu, (const void*)fwd_kernel, NWAVES * 64, LDS_BYTES) != hipSuccess || per_cu < 1)
            fprintf(stderr, "kernel_launch: note: occupancy query reports %d workgroups per CU\n", per_cu);
        (void)hipGetLastError();
        grid = cus;
        if (grid != 256) fprintf(stderr, "kernel_launch: note: %d CUs (built for 256)\n", grid);
    }
    if (grid < 0) return;
    if (hipMemsetAsync((char*)d_ws + WS_CTL, 0, CTL_ZERO_BYTES, stream) != hipSuccess) { fprintf(stderr, "kernel_launch: memset failed\n"); return; }
    Args a{};
    for (int i = 0; i < N_IN; ++i) a.in[i] = (const float*)d_in[i];
    a.out = (float*)d_out; a.ws = (unsigned char*)d_ws;
#if MK_PER_PHASE
    for (int pid = 0; pid < NPH; ++pid) {
        if (!phase_exists(pid)) continue;
        a.ph_lo = pid; a.ph_hi = pid + 1;
        hipLaunchKernelGGL(fwd_kernel, dim3(grid), dim3(NWAVES * 64), LDS_BYTES, stream, a);
    }
#else
    a.ph_lo = 0; a.ph_hi = NPH;
    hipLaunchKernelGGL(fwd_kernel, dim3(grid), dim3(NWAVES * 64), LDS_BYTES, stream, a);
#endif
    const hipError_t le = hipPeekAtLastError();
    if (le != hipSuccess) fprintf(stderr, "kernel_launch: launch failed: %s\n", hipGetErrorName(le));
}
```

```cpp
#include <hip/hip_runtime.h>
#include <cstdio>
#include <cstdint>
namespace pg8 {
#define PG8_LAS __attribute__((address_space(3)))
typedef unsigned short bf16_t;
typedef short bf16x8 __attribute__((ext_vector_type(8)));
typedef float f32x4 __attribute__((ext_vector_type(4)));
typedef float f32x2 __attribute__((ext_vector_type(2)));
typedef unsigned u32x4 __attribute__((ext_vector_type(4)));
typedef unsigned u32x2 __attribute__((ext_vector_type(2)));
constexpr int BM = 256, BK = 64, HALF = 128, HTB = HALF * BK * 2  , STAGE_BYTES = 8 * HTB, NXCD = 8, WGM = 8;

__host__ __device__ __forceinline__ int lds_byte(int r, int c) { const int st = (r >> 4) * 2 + (c >> 5), rr = r & 15, cc = c & 31, ob = rr * 64 + cc * 2; return st * 1024 + (ob ^ (((ob >> 9) & 1) << 5)); }
__host__ __device__ __forceinline__ void stage_rc(int b, int& R, int& C) { const int st = b / 1024, sb = b % 1024, swz = sb ^ (((sb >> 9) & 1) << 5); R = (st >> 1) * 16 + swz / 64; C = (st & 1) * 32 + (swz % 64) / 2; }
__host__ __device__ __forceinline__ int perm32(int rho) { const int n = rho >> 4, i = rho & 15; return 8 * (i >> 2) + 4 * n + (i & 3); }

__host__ __device__ __forceinline__ int lds_byte8(int r, int cb) { return r * 128 + ((((cb >> 5) ^ ((r >> 1) & 3)) & 3) << 5) + (cb & 31); }
__host__ __device__ __forceinline__ void stage_rc8(int b, int& R, int& Cb) { R = b >> 7; Cb = ((((b >> 5) & 3) ^ ((R >> 1) & 3)) << 5) + (b & 31); }
struct Unit { int pm, pn; };
struct Gemm { const char* A; const char* Bt; int K; unsigned lda, ldb, kstepA; };

__device__ __forceinline__ bool tile_from_L(long L, int nM, int nN, Unit& u);
__device__ __forceinline__ bool tile_order(int i, int G, int c, int nM, int nN, Unit& u) { return tile_from_L((long)i * G + c, nM, nN, u); }
__device__ __forceinline__ bool tile_from_L(long L, int nM, int nN, Unit& u) {
    const int nwg = nM * nN; if (L >= nwg) return false;
    int wgid = (int)L; { const int q = nwg / NXCD, r = nwg % NXCD, xcd = wgid % NXCD, off = wgid / NXCD; wgid = (xcd < r ? xcd * (q + 1) : r * (q + 1) + (xcd - r) * q) + off; }
    const int nig = WGM * nN, gid = wgid / nig, fm = gid * WGM, gsz = (nM - fm) < WGM ? (nM - fm) : WGM;
    u.pm = fm + ((wgid % nig) % gsz); u.pn = (wgid % nig) / gsz; return true;
}
struct StaticOrder {
    int nM, nN, G, c;
    __device__ __forceinline__ void init(int M, int N, int G_, int c_) { nM = M / BM; nN = N / BM; G = G_; c = c_; }
    __device__ __forceinline__ bool next(int i, Unit& u) const { return tile_order(i, G, c, nM, nN, u); }
    __device__ __forceinline__ const char* a_ptr(const Gemm& g, const Unit& u) const { return g.A + (size_t)u.pm * ((size_t)BM * g.lda * 2); }
    __device__ __forceinline__ const char* b_ptr(const Gemm& g, const Unit& u) const { return g.Bt + (size_t)u.pn * ((size_t)BM * g.ldb * 2); }
};

typedef __bf16 bf16x2_hw __attribute__((ext_vector_type(2)));
typedef float f32x2_hw __attribute__((ext_vector_type(2)));
__device__ __forceinline__ unsigned cvt_pk_bf16(float lo, float hi) { return __builtin_bit_cast(unsigned, __builtin_convertvector((f32x2_hw){lo, hi}, bf16x2_hw)); }
#ifndef MK_WT
#define MK_WT 1
#endif
__device__ __forceinline__ void st16_out(void* p, u32x4 v) { if (MK_WT) asm volatile("global_store_dwordx4 %0, %1, off sc1\n\ts_nop 1" :: "v"(p), "v"(v) : "memory");     else *(u32x4*)p = v; }
__device__ __forceinline__ void st8_out(void* p, u32x2 v) { if (MK_WT) asm volatile("global_store_dwordx2 %0, %1, off sc1" :: "v"(p), "v"(v) : "memory"); else *(u32x2*)p = v; }
__device__ __forceinline__ float gelu_tanh(float x) {
    const float u = x * (1.5957691216f + 0.0713548163f * x * x);
    const float e = __builtin_amdgcn_exp2f(-1.4426950409f * u);
    return x * __builtin_amdgcn_rcpf(1.0f + e);
}
__device__ __forceinline__ f32x2_hw gelu_tanh2(f32x2_hw x) {
    const f32x2_hw t = x * (x * x * (-1.4426950409f * 0.0713548163f) + (-1.4426950409f * 1.5957691216f));
    f32x2_hw d; d.x = __builtin_amdgcn_exp2f(t.x); d.y = __builtin_amdgcn_exp2f(t.y); d = d + 1.0f;
    f32x2_hw r; r.x = __builtin_amdgcn_rcpf(d.x); r.y = __builtin_amdgcn_rcpf(d.y);
    return x * r;
}
__device__ __forceinline__ f32x2_hw silu_mul2(f32x2_hw g, f32x2_hw u, float k1  , float k2  ) {
    const f32x2_hw t = g * k1; f32x2_hw d; d.x = __builtin_amdgcn_exp2f(t.x); d.y = __builtin_amdgcn_exp2f(t.y); d = d + 1.0f;
    f32x2_hw r; r.x = __builtin_amdgcn_rcpf(d.x); r.y = __builtin_amdgcn_rcpf(d.y);
    return (g * u) * (r * k2);
}
__device__ __forceinline__ float silu_f(float x) { return x * __builtin_amdgcn_rcpf(1.0f + __builtin_amdgcn_exp2f(-1.4426950409f * x)); }
__device__ __forceinline__ float sigmoid_f(float x) { return __builtin_amdgcn_rcpf(1.0f + __builtin_amdgcn_exp2f(-1.4426950409f * x)); }

template <int ACT  > struct EpiBf16 {
    static constexpr bool PERM = true;
    bf16_t* O; int ldc; const float* bias0; int split_cols; size_t split_stride; float scale; int brow_shift, brow_stride;
    __device__ __forceinline__ void operator()(const f32x4 (&acc)[2][2][4][2], const Unit& u, int wr, int wc, int fr, int fq) const {
        const float* bias = bias0; if (bias0 && brow_shift >= 0) bias = bias0 + (u.pm >> brow_shift) * brow_stride;
        const int row0 = u.pm * BM + wr * 64 + fr; int colt = u.pn * BM; bf16_t* base = O;
        if (split_cols) { const int t = colt / split_cols; base += (size_t)t * split_stride; colt -= t * split_cols; }
        const int col0 = colt + wc * 32 + 8 * fq, bcol0 = u.pn * BM + wc * 32 + 8 * fq;
        f32x4 bv[2][2];
#pragma unroll
        for (int bj = 0; bj < 2; ++bj)
#pragma unroll
            for (int n = 0; n < 2; ++n) bv[bj][n] = bias ? *(const f32x4*)(bias + bcol0 + bj * HALF + 4 * n) : (f32x4){0.f, 0.f, 0.f, 0.f};
#pragma unroll
        for (int ai = 0; ai < 2; ++ai)
#pragma unroll
            for (int m = 0; m < 4; ++m) { bf16_t* rowp = base + (size_t)(row0 + ai * HALF + m * 16) * ldc + col0;
#pragma unroll
                for (int bj = 0; bj < 2; ++bj) { f32x4 v0 = acc[ai][bj][m][0], v1 = acc[ai][bj][m][1]; if (bias) { v0 = v0 + bv[bj][0]; v1 = v1 + bv[bj][1]; }
                    if (ACT == 1) {
                        const f32x2_hw a0 = gelu_tanh2((f32x2_hw){v0[0], v0[1]}), a1 = gelu_tanh2((f32x2_hw){v0[2], v0[3]}), a2 = gelu_tanh2((f32x2_hw){v1[0], v1[1]}), a3 = gelu_tanh2((f32x2_hw){v1[2], v1[3]});
                        v0 = (f32x4){a0.x, a0.y, a1.x, a1.y}; v1 = (f32x4){a2.x, a2.y, a3.x, a3.y}; }
                    v0 = v0 * scale; v1 = v1 * scale; u32x4 w; w.x = cvt_pk_bf16(v0[0], v0[1]); w.y = cvt_pk_bf16(v0[2], v0[3]); w.z = cvt_pk_bf16(v1[0], v1[1]); w.w = cvt_pk_bf16(v1[2], v1[3]);
                    st16_out(rowp + bj * HALF, w); } }
    }
};
struct EpiSwiglu {
    static constexpr bool PERM = true;
    bf16_t* O; int ldc;
    __device__ __forceinline__ void operator()(const f32x4 (&acc)[2][2][4][2], const Unit& u, int wr, int wc, int fr, int fq) const {
        const int row0 = u.pm * BM + wr * 64 + fr, col0 = u.pn * HALF + wc * 32 + 8 * fq;
#pragma unroll
        for (int ai = 0; ai < 2; ++ai)
#pragma unroll
            for (int m = 0; m < 4; ++m) { bf16_t* rowp = O + (size_t)(row0 + ai * HALF + m * 16) * ldc + col0;
                f32x4 v0, v1;
#pragma unroll
                for (int j = 0; j < 4; j += 2) { const f32x2_hw a = silu_mul2((f32x2_hw){acc[ai][0][m][0][j], acc[ai][0][m][0][j + 1]}, (f32x2_hw){acc[ai][1][m][0][j], acc[ai][1][m][0][j + 1]}, -1.4426950409f, 1.0f),
                                                                b = silu_mul2((f32x2_hw){acc[ai][0][m][1][j], acc[ai][0][m][1][j + 1]}, (f32x2_hw){acc[ai][1][m][1][j], acc[ai][1][m][1][j + 1]}, -1.4426950409f, 1.0f);
                    v0[j] = a.x; v0[j + 1] = a.y; v1[j] = b.x; v1[j + 1] = b.y; }
                u32x4 w; w.x = cvt_pk_bf16(v0[0], v0[1]); w.y = cvt_pk_bf16(v0[2], v0[3]); w.z = cvt_pk_bf16(v1[0], v1[1]); w.w = cvt_pk_bf16(v1[2], v1[3]);
                st16_out(rowp, w); }
    }
};
struct EpiSwigluS {
    static constexpr bool PERM = true;
    bf16_t* O; int ldc; float inscale;
    __device__ __forceinline__ void operator()(const f32x4 (&acc)[2][2][4][2], const Unit& u, int wr, int wc, int fr, int fq) const {
        const int row0 = u.pm * BM + wr * 64 + fr, col0 = u.pn * HALF + wc * 32 + 8 * fq;
#pragma unroll
        for (int ai = 0; ai < 2; ++ai)
#pragma unroll
            for (int m = 0; m < 4; ++m) { bf16_t* rowp = O + (size_t)(row0 + ai * HALF + m * 16) * ldc + col0;
                f32x4 v0, v1;
                float k1 = -1.4426950409f * inscale, k2 = inscale * inscale;
                asm volatile("" : "+s"(k1), "+s"(k2));
#pragma unroll
                for (int j = 0; j < 4; j += 2) { const f32x2_hw a = silu_mul2((f32x2_hw){acc[ai][0][m][0][j], acc[ai][0][m][0][j + 1]}, (f32x2_hw){acc[ai][1][m][0][j], acc[ai][1][m][0][j + 1]}, k1, k2),
                                                                b = silu_mul2((f32x2_hw){acc[ai][0][m][1][j], acc[ai][0][m][1][j + 1]}, (f32x2_hw){acc[ai][1][m][1][j], acc[ai][1][m][1][j + 1]}, k1, k2);
                    v0[j] = a.x; v0[j + 1] = a.y; v1[j] = b.x; v1[j + 1] = b.y; }
                u32x4 w; w.x = cvt_pk_bf16(v0[0], v0[1]); w.y = cvt_pk_bf16(v0[2], v0[3]); w.z = cvt_pk_bf16(v1[0], v1[1]); w.w = cvt_pk_bf16(v1[2], v1[3]);
                st16_out(rowp, w); }
    }
};
struct EpiQG {
    static constexpr bool PERM = true;
    bf16_t* Q; float* G; float qscale;
    __device__ __forceinline__ void operator()(const f32x4 (&acc)[2][2][4][2], const Unit& u, int wr, int wc, int fr, int fq) const {
        const int row0 = u.pm * BM + wr * 64 + fr;
        if (u.pn < 4) {
            const int col0 = u.pn * BM + wc * 32 + 8 * fq;
#pragma unroll
            for (int ai = 0; ai < 2; ++ai)
#pragma unroll
                for (int m = 0; m < 4; ++m) { bf16_t* rowp = Q + (size_t)(row0 + ai * HALF + m * 16) * 1024 + col0;
#pragma unroll
                    for (int bj = 0; bj < 2; ++bj) { const f32x4 v0 = acc[ai][bj][m][0] * qscale, v1 = acc[ai][bj][m][1] * qscale;
                        u32x4 w; w.x = cvt_pk_bf16(v0[0], v0[1]); w.y = cvt_pk_bf16(v0[2], v0[3]); w.z = cvt_pk_bf16(v1[0], v1[1]); w.w = cvt_pk_bf16(v1[2], v1[3]);
                        st16_out(rowp + bj * HALF, w); } }
        } else {
            const int c0 = wc * 32 + 8 * fq;
            if (c0 < 48) {
#pragma unroll
                for (int ai = 0; ai < 2; ++ai)
#pragma unroll
                    for (int m = 0; m < 4; ++m) { float* rowp = G + (size_t)(row0 + ai * HALF + m * 16) * 48 + c0;
                        f32x4 v0, v1;
#pragma unroll
                        for (int j = 0; j < 4; ++j) { v0[j] = sigmoid_f(acc[ai][0][m][0][j]); v1[j] = sigmoid_f(acc[ai][0][m][1][j]); }
                        st16_out(rowp, __builtin_bit_cast(u32x4, v0)); st16_out(rowp + 4, __builtin_bit_cast(u32x4, v1)); }
            }
        }
    }
};

typedef int v8i __attribute__((ext_vector_type(8)));
typedef int v4i __attribute__((ext_vector_type(4)));
__device__ __forceinline__ float clamp448(float x) { return __builtin_amdgcn_fmed3f(x, -448.0f, 448.0f); }
__device__ __forceinline__ unsigned pk4_fp8(float a, float b, float c, float d) {
    unsigned w; a = clamp448(a); b = clamp448(b); c = clamp448(c); d = clamp448(d);
    asm volatile("v_cvt_pk_fp8_f32 %0, %1, %2" : "=v"(w) : "v"(a), "v"(b));
    asm volatile("v_cvt_pk_fp8_f32 %0, %1, %2 op_sel:[0,0,1]" : "+v"(w) : "v"(c), "v"(d));
    return w; }
struct EpiSwigluF8 {
    static constexpr bool PERM = true;
    unsigned char* O; int ldc; float inscale, outscale; unsigned* cnt; int npan;
    __device__ __forceinline__ void operator()(const f32x4 (&acc)[2][2][4][2], const Unit& u, int wr, int wc, int fr, int fq) const {
        const int row0 = u.pm * BM + wr * 64 + fr, col0 = u.pn * HALF + wc * 32 + 8 * fq;
#pragma unroll
        for (int ai = 0; ai < 2; ++ai)
#pragma unroll
            for (int m = 0; m < 4; ++m) { unsigned char* rowp = O + (size_t)(row0 + ai * HALF + m * 16) * ldc + col0;
                f32x4 v0, v1;
                float k1 = -1.4426950409f * inscale, k2 = inscale * inscale * outscale;
                asm volatile("" : "+s"(k1), "+s"(k2));
#pragma unroll
                for (int j = 0; j < 4; j += 2) { const f32x2_hw a = silu_mul2((f32x2_hw){acc[ai][0][m][0][j], acc[ai][0][m][0][j + 1]}, (f32x2_hw){acc[ai][1][m][0][j], acc[ai][1][m][0][j + 1]}, k1, k2),
                                                                b = silu_mul2((f32x2_hw){acc[ai][0][m][1][j], acc[ai][0][m][1][j + 1]}, (f32x2_hw){acc[ai][1][m][1][j], acc[ai][1][m][1][j + 1]}, k1, k2);
                    v0[j] = a.x; v0[j + 1] = a.y; v1[j] = b.x; v1[j + 1] = b.y; }
                u32x2 w; w.x = pk4_fp8(v0[0], v0[1], v0[2], v0[3]); w.y = pk4_fp8(v1[0], v1[1], v1[2], v1[3]);
                st8_out(rowp, w); }
        if (u.pm < npan) {
            asm volatile("s_waitcnt vmcnt(0)" ::: "memory");
            if (fr == 0 && fq == 0) __hip_atomic_fetch_add(cnt + u.pm, 1u, __ATOMIC_RELAXED, __HIP_MEMORY_SCOPE_AGENT);
        }
    }
};
template <class Epi, class Sched, bool ALIGN_EPI = true, bool F8 = false>
__device__ __forceinline__ void gemm_phase(const int tid, PG8_LAS unsigned char* lds, const Gemm g, const Sched& S, const Epi& E) {
    const int wid = __builtin_amdgcn_readfirstlane(tid >> 6), lane = tid & 63, wr = wid >> 2, wc = wid & 3, fr = lane & 15, fq = lane >> 4;
    const int K = g.K, nt = K / BK;
    unsigned voffA[2], voffB[2];
#pragma unroll
    for (int i = 0; i < 2; ++i) { int R, C; if constexpr (F8) { int Cb; stage_rc8(tid * 16 + i * 8192, R, Cb); C = Cb >> 1; } else stage_rc(tid * 16 + i * 8192, R, C);
        const int Rb = Epi::PERM ? ((R & ~31) + perm32(R & 31)) : R;
        voffA[i] = (unsigned)(R * g.lda + C) * 2u; voffB[i] = (unsigned)(Rb * g.ldb + C) * 2u; }
    const size_t kstepA = (size_t)g.kstepA, kstepB = (size_t)(BK * 2);
    const size_t hstepA = (size_t)HALF * g.lda * 2, hstepB = (size_t)HALF * g.ldb * 2;
    const unsigned ldsw = (unsigned)wid * 1024u;
    const int aoff = F8 ? lds_byte8(wr * 64 + fr, fq * 32) : lds_byte(wr * 64 + fr, fq * 8), boff = F8 ? lds_byte8(wc * 32 + fr, fq * 32) : lds_byte(wc * 32 + fr, fq * 8);
#define PG8_SA(b, h) (((b) * 2 + (h)) * HTB)
#define PG8_SB(b, h) ((4 + (b) * 2 + (h)) * HTB)
#define PG8_STAGE(bufoff, gbase, voff) do { _Pragma("unroll") for (int _i = 0; _i < 2; ++_i) \
        __builtin_amdgcn_global_load_lds((const unsigned*)((const char*)(gbase) + (voff)[_i]), (PG8_LAS unsigned*)(lds + (bufoff) + ldsw + _i * 8192), 16, 0, 0); } while (0)
#define PG8_LDA(dst, b, h) do { _Pragma("unroll") for (int m = 0; m < 4; ++m) { if constexpr (F8) dst##8[m] = *(const PG8_LAS v8i*)(lds + PG8_SA(b, h) + aoff + m * 2048); else { _Pragma("unroll") for (int k = 0; k < 2; ++k) dst[m][k] = *(const PG8_LAS bf16x8*)(lds + PG8_SA(b, h) + aoff + m * 2048 + k * 1024); } } } while (0)
#define PG8_LDB(dst, b, h) do { _Pragma("unroll") for (int n = 0; n < 2; ++n) { if constexpr (F8) dst##8[n] = *(const PG8_LAS v8i*)(lds + PG8_SB(b, h) + boff + n * 2048); else { _Pragma("unroll") for (int k = 0; k < 2; ++k) dst[n][k] = *(const PG8_LAS bf16x8*)(lds + PG8_SB(b, h) + boff + n * 2048 + k * 1024); } } } while (0)
#define PG8_MMA(ai, bj, At, Bt) do { __builtin_amdgcn_s_setprio(1); _Pragma("unroll") for (int m = 0; m < 4; ++m) _Pragma("unroll") for (int n = 0; n < 2; ++n) { \
        if constexpr (F8) { asm volatile("v_mfma_scale_f32_16x16x128_f8f6f4 %0, %1, %2, %0, %3, %3 op_sel_hi:[0,0,0]" : "+v"(acc[ai][bj][m][n]) : "v"(Bt##8[n]), "v"(At##8[m]), "v"(one_scale)); } \
        else { _Pragma("unroll") for (int k = 0; k < 2; ++k) acc[ai][bj][m][n] = __builtin_amdgcn_mfma_f32_16x16x32_bf16(Bt[n][k], At[m][k], acc[ai][bj][m][n], 0, 0, 0); } } __builtin_amdgcn_s_setprio(0); } while (0)
#define PG8_WAIT_V(n) asm volatile("s_waitcnt vmcnt(" #n ")" ::: "memory")
#define PG8_WAIT_L(n) asm volatile("s_waitcnt lgkmcnt(" #n ")" ::: "memory")
#define PG8_BAR __builtin_amdgcn_s_barrier()
#define PG8_SCHED __builtin_amdgcn_sched_barrier(0)
    Unit cur, nxt; int ui = 0;
    if (!S.next(0, cur)) return;
    f32x4 acc[2][2][4][2];
#pragma unroll
    for (int a = 0; a < 2; ++a)
#pragma unroll
        for (int b = 0; b < 2; ++b)
#pragma unroll
            for (int m = 0; m < 4; ++m)
#pragma unroll
                for (int n = 0; n < 2; ++n) acc[a][b][m][n] = (f32x4){0.f, 0.f, 0.f, 0.f};
    bf16x8 At[4][2], B0[2][2], B1[2][2]; v8i At8[4], B08[2], B18[2]; int one_scale = 0x7f7f7f7f; asm volatile("" : "+v"(one_scale));
    const char* cA = S.a_ptr(g, cur); const char* cB = S.b_ptr(g, cur);
    PG8_STAGE(PG8_SB(0, 0), cB, voffB); PG8_STAGE(PG8_SB(0, 1), cB + hstepB, voffB); PG8_STAGE(PG8_SA(0, 0), cA, voffA); PG8_STAGE(PG8_SA(0, 1), cA + hstepA, voffA);
    if (wr == 1) PG8_BAR;
    PG8_WAIT_V(2); PG8_BAR;
    PG8_STAGE(PG8_SB(1, 0), cB + kstepB, voffB); PG8_STAGE(PG8_SA(1, 0), cA + kstepA, voffA); PG8_STAGE(PG8_SB(1, 1), cB + hstepB + kstepB, voffB);
    PG8_WAIT_V(6); PG8_BAR;
    for (;;) {
        const bool has_next = S.next(ui + 1, nxt);
        const char* nA = has_next ? S.a_ptr(g, nxt) : cA; const char* nB = has_next ? S.b_ptr(g, nxt) : cB;
#pragma nounroll
        for (int t = 0; t < nt; t += 2) {
            const bool last = (t == nt - 2);
            const char* a1 = cA + (size_t)(t + 1) * kstepA;
            const char* a2 = last ? nA : cA + (size_t)(t + 2) * kstepA; const char* b2 = last ? nB : cB + (size_t)(t + 2) * kstepB;
            const char* a3 = a2 + kstepA; const char* b3 = b2 + kstepB;
            PG8_LDB(B0, 0, 0); PG8_LDB(B1, 0, 1); PG8_SCHED; PG8_LDA(At, 0, 0); PG8_STAGE(PG8_SA(1, 1), a1 + hstepA, voffA);
            PG8_WAIT_V(8); PG8_WAIT_L(0); PG8_BAR; PG8_MMA(0, 0, At, B0); PG8_MMA(0, 1, At, B1); PG8_BAR; PG8_SCHED;
            PG8_LDA(At, 0, 1); PG8_STAGE(PG8_SB(0, 0), b2, voffB); PG8_STAGE(PG8_SB(0, 1), b2 + hstepB, voffB); PG8_STAGE(PG8_SA(0, 0), a2, voffA);
            PG8_WAIT_V(8); PG8_WAIT_L(0); PG8_BAR; PG8_MMA(1, 0, At, B0); PG8_MMA(1, 1, At, B1); PG8_BAR; PG8_SCHED;
            PG8_LDB(B0, 1, 0); PG8_LDB(B1, 1, 1); PG8_SCHED; PG8_LDA(At, 1, 0); PG8_STAGE(PG8_SA(0, 1), a2 + hstepA, voffA);
            PG8_WAIT_V(8); PG8_WAIT_L(0); PG8_BAR; PG8_MMA(0, 0, At, B0); PG8_MMA(0, 1, At, B1); PG8_BAR; PG8_SCHED;
            PG8_LDA(At, 1, 1); PG8_STAGE(PG8_SB(1, 0), b3, voffB); PG8_STAGE(PG8_SB(1, 1), b3 + hstepB, voffB); PG8_STAGE(PG8_SA(1, 0), a3, voffA);
            PG8_WAIT_V(8); PG8_WAIT_L(0); PG8_BAR; PG8_MMA(1, 0, At, B0); PG8_MMA(1, 1, At, B1); PG8_BAR; PG8_SCHED;
        }
        if constexpr (ALIGN_EPI) { if (wr == 0) PG8_BAR; }
        if constexpr (F8) asm volatile("s_nop 15\n\ts_nop 15\n\ts_nop 15" ::: "memory");
        E(acc, cur, wr, wc, fr, fq);
        if (!has_next) break;
#pragma unroll
        for (int a = 0; a < 2; ++a)
#pragma unroll
            for (int b = 0; b < 2; ++b)
#pragma unroll
                for (int m = 0; m < 4; ++m)
#pragma unroll
                    for (int n = 0; n < 2; ++n) acc[a][b][m][n] = (f32x4){0.f, 0.f, 0.f, 0.f};
        cur = nxt; cA = nA; cB = nB; ++ui;
        if constexpr (ALIGN_EPI) { if (wr == 1) PG8_BAR; }
    }
    PG8_WAIT_V(0);
    if constexpr (!ALIGN_EPI) { if (wr == 0) PG8_BAR; }
    PG8_BAR;
#undef PG8_SA
#undef PG8_SB
#undef PG8_STAGE
#undef PG8_LDA
#undef PG8_LDB
#undef PG8_MMA
#undef PG8_WAIT_V
#undef PG8_WAIT_L
#undef PG8_BAR
#undef PG8_SCHED
}
}
constexpr int NWAVES = 8;
constexpr int M = 16384, D = 1024, DEPTH = 4;
constexpr int A_W = 2048, A_G = 8, CHUNK = 128;
constexpr int NH = 16, NKV = 4, HPG = 4, HD = 64;
constexpr int N_CMP = 1023, NCMP_P = 1024;
constexpr int DFF = 2816, NEXP = 8, DEXP = 3584, MOE_BLK = 256;
constexpr int MOE_ROWS = 2 * M + NEXP * MOE_BLK;
constexpr int NQG = 1280;
constexpr float EPS = 1e-6f;
constexpr int MODC = 8 * 3072 + 2048 + 512;
constexpr int MODKS = 16;

constexpr size_t MiB = 1u << 20;
constexpr size_t WS_CTL = 0, CTL_ZERO_BYTES = 1 * MiB;
constexpr size_t WS_MODP = 1 * MiB;
constexpr size_t WS_MOD = 3 * MiB + 8192;
constexpr size_t WS_CB1 = 3 * MiB;
constexpr size_t WS_ROUTE = 3 * MiB + 131072;
constexpr int KP2 = 2048 + 64;
constexpr size_t WS_W = 4 * MiB;
constexpr size_t W_AIN = WS_W;
constexpr size_t W_AOUT = W_AIN + (size_t)2 * 4096 * 1024 * 2;
constexpr size_t W_KV = W_AOUT + (size_t)2 * 1024 * KP2 * 2;
constexpr size_t W_C1 = W_KV + (size_t)1536 * 1024 * 2;
constexpr size_t W_C2 = W_C1 + (size_t)2 * 256 * 2048 * 2;
constexpr size_t W_BIN = W_C2 + (size_t)2 * 64 * 256 * 2;
constexpr size_t W_BOUT = W_BIN + (size_t)2 * NQG * 1024 * 2;
constexpr size_t W_FGU = W_BOUT + (size_t)2 * 1024 * 1024 * 2;
constexpr size_t W_FD = W_FGU + (size_t)2 * 5632 * 1024 * 2;
constexpr size_t W_MGU = W_FD + (size_t)2 * 1024 * 2816 * 2;
constexpr size_t W_MD = W_MGU + (size_t)16 * 7168 * 1024 * 2;
constexpr size_t W_END = W_MD + (size_t)16 * 1024 * 3584 * 2;
constexpr size_t WS_H = (W_END + MiB - 1) / MiB * MiB;
constexpr size_t WS_Y = WS_H + 32 * MiB;
constexpr size_t WS_KV = WS_Y + 32 * MiB;
constexpr size_t WS_VT = WS_KV + 49 * MiB;
constexpr size_t WS_KCMP = WS_VT + 16 * MiB;
constexpr size_t WS_VCMPT = WS_KCMP + 512 * 1024;
constexpr size_t WS_X16 = WS_VCMPT + 512 * 1024;
constexpr size_t WS_UNI = WS_X16 + 32 * MiB;
constexpr size_t WS_U = WS_UNI, WS_V = WS_U + 64 * MiB, WS_UM = WS_V + 64 * MiB;
constexpr size_t WS_ACT = WS_UNI;
constexpr float MOE_SW_GU = 32.0f, MOE_SW_D = 64.0f, MOE_SA = 4.0f;
#ifndef FFN_F8
#define FFN_F8 1
#endif
#ifndef M3_SPLIT
#define M3_SPLIT 0
#endif
constexpr size_t WS_XBUF = WS_UNI;
constexpr size_t WS_XBUF2 = WS_XBUF;
constexpr size_t WS_YBUF = WS_XBUF + 128 * MiB;
constexpr size_t WS_ACTM = WS_YBUF + 68 * MiB;
constexpr size_t WS_HKV = WS_ACTM;
constexpr size_t WS_Q = WS_UNI + 32 * MiB;
constexpr size_t WS_G = WS_Q + 32 * MiB;
constexpr size_t WS_O = WS_G + 4 * MiB;
constexpr size_t WS_HID = WS_O + 32 * MiB;
constexpr size_t WS_END = WS_UNI + 374 * MiB;
static_assert(WS_ACTM + (size_t)MOE_ROWS * DEXP <= WS_END && (size_t)MOE_ROWS * 1024 * 2 <= 68 * MiB && (size_t)8 * 16384 * 1024 <= 128 * MiB && (size_t)(M + 64) * 1536 * 2 <= 49 * MiB, "ws map");
static_assert((size_t)MODKS * MODC * 4 <= 2 * MiB, "modp");

constexpr int CW_TMO = 0, CW_CODE = 1;
constexpr int CW_BAR = 4096;
constexpr int CW_KMAX = 12288;
constexpr int CW_EARLY = 14336;
__host__ __device__ __forceinline__ int moe_early_tiles(int nM, int G) { const int e = (4 * nM) % G; return (G == 256 && e <= 64 && 4 * nM >= 2 * G) ? e : 0; }
constexpr int CW_MOE = 8192;

constexpr int RING_OFF = 0, RING_BYTES = 131072;
constexpr int LDSCTL_OFF = RING_BYTES, MISC_OFF = LDSCTL_OFF + 320;
constexpr int LDS_BYTES = 147456;
constexpr int SLC_BM_OFF = RING_BYTES + 1024, SLC_MREF_OFF = SLC_BM_OFF + 2048, SLC_LACC_OFF = SLC_MREF_OFF + 1024;
static_assert(SLC_LACC_OFF + 4096 <= LDS_BYTES && MISC_OFF + 128 <= SLC_BM_OFF, "LDS map");

#define GAS __attribute__((address_space(1)))
#define LAS __attribute__((address_space(3)))
typedef unsigned short bf16;
typedef unsigned v4u __attribute__((ext_vector_type(4)));
typedef unsigned v2u __attribute__((ext_vector_type(2)));
typedef float f32x4 __attribute__((ext_vector_type(4)));
typedef short bf16x8 __attribute__((ext_vector_type(8)));
typedef short bf16x4 __attribute__((ext_vector_type(4)));
typedef GAS unsigned gu32;
#define RLX_AGENT __ATOMIC_RELAXED, __HIP_MEMORY_SCOPE_AGENT
#define LDS_WAIT() asm volatile("s_waitcnt lgkmcnt(0)" ::: "memory")
#define VM_WAIT() asm volatile("s_waitcnt vmcnt(0)" ::: "memory")
__device__ __forceinline__ float shx(float v, int lane, int m) { return __builtin_bit_cast(float, __builtin_amdgcn_ds_bpermute((lane ^ m) << 2, __builtin_bit_cast(int, v))); }
__device__ __forceinline__ float shl_from(float v, int src_lane) { return __builtin_bit_cast(float, __builtin_amdgcn_ds_bpermute(src_lane << 2, __builtin_bit_cast(int, v))); }
__device__ __forceinline__ unsigned f2bf(float f) { unsigned u = __builtin_bit_cast(unsigned, f); return (u + 0x7fffu + ((u >> 16) & 1u)) >> 16; }
__device__ __forceinline__ unsigned pk2(float lo, float hi) { return pg8::cvt_pk_bf16(lo, hi); }
__device__ __forceinline__ float bf_lo(unsigned w) { return __builtin_bit_cast(float, w << 16); }
__device__ __forceinline__ float bf_hi(unsigned w) { return __builtin_bit_cast(float, w & 0xffff0000u); }
__device__ __forceinline__ int dpp_xor1i(int v) { return __builtin_amdgcn_update_dpp(v, v, 0xB1, 0xF, 0xF, false); }
__device__ __forceinline__ int dpp_xor2i(int v) { return __builtin_amdgcn_update_dpp(v, v, 0x4E, 0xF, 0xF, false); }
__device__ __forceinline__ int dpp_hmiri(int v) { return __builtin_amdgcn_update_dpp(v, v, 0x141, 0xF, 0xF, false); }
__device__ __forceinline__ int dpp_miri(int v)  { return __builtin_amdgcn_update_dpp(v, v, 0x140, 0xF, 0xF, false); }
__device__ __forceinline__ float dpp_xor1(float v) { return __builtin_bit_cast(float, dpp_xor1i(__builtin_bit_cast(int, v))); }
__device__ __forceinline__ float dpp_xor2(float v) { return __builtin_bit_cast(float, dpp_xor2i(__builtin_bit_cast(int, v))); }
__device__ __forceinline__ float dpp_hmir(float v) { return __builtin_bit_cast(float, dpp_hmiri(__builtin_bit_cast(int, v))); }
__device__ __forceinline__ float dpp_mir(float v)  { return __builtin_bit_cast(float, dpp_miri(__builtin_bit_cast(int, v))); }
__device__ __forceinline__ float wave_sum(float v) {
    v += dpp_xor1(v); v += dpp_xor2(v); v += dpp_hmir(v); v += dpp_mir(v);
    const int b = __builtin_bit_cast(int, v);
    const float r0 = __builtin_bit_cast(float, __builtin_amdgcn_readlane(b, 0)), r1 = __builtin_bit_cast(float, __builtin_amdgcn_readlane(b, 16)),
                r2 = __builtin_bit_cast(float, __builtin_amdgcn_readlane(b, 32)), r3 = __builtin_bit_cast(float, __builtin_amdgcn_readlane(b, 48));
    return (r0 + r1) + (r2 + r3);
}

#define XB_TMO      128
#define XB_XCNT(j)  (256  + 64 * (j))
#define XB_XSUB(j)  (1280 + 64 * (j))
#define XB_XGEN(j)  (2304 + 64 * (j))
#define XB_TOP      3328
#define XB_TOPGEN   3392
#define XCD_BAR_WORDS 3456
#define XB_SPIN_CAP (1u << 22)

__device__ __forceinline__ unsigned xb_ld(unsigned* p)              { return __hip_atomic_load(p, __ATOMIC_RELAXED, __HIP_MEMORY_SCOPE_AGENT); }
__device__ __forceinline__ unsigned xb_add(unsigned* p, unsigned v) { return __hip_atomic_fetch_add(p, v, __ATOMIC_RELAXED, __HIP_MEMORY_SCOPE_AGENT); }
__device__ __forceinline__ unsigned xb_xcc_id() { return (unsigned)__builtin_amdgcn_s_getreg((3 << 11) | 20) & 0xFu; }
#define XB_SPIN(cond, bar) do { unsigned _sp = 0; while (cond) { __builtin_amdgcn_s_sleep(1); \
    if ((++_sp & 255u) == 0u) { if (xb_ld(&(bar)[XB_TMO])) break; if (_sp > XB_SPIN_CAP) { atomicAdd(&(bar)[XB_TMO], 1u); break; } } } } while (0)

struct XcdBarrier { unsigned* bar; unsigned x; volatile LAS unsigned* st; };

__device__ __forceinline__ XcdBarrier xcd_barrier_post(unsigned* bar, volatile LAS unsigned* st) {
    XcdBarrier b; b.bar = bar; b.x = xb_xcc_id(); b.st = st;
    if (threadIdx.x == 0) (void)xb_add(&bar[XB_XCNT(b.x)], 1u);
    return b;
}
__device__ __forceinline__ void xcd_barrier_complete(unsigned* bar, unsigned x, unsigned& nloc, unsigned& nx) {
    const unsigned G = gridDim.x * gridDim.y * gridDim.z;
    unsigned sum, cnt, mine, sp = 0u;
    for (;;) {
        sum = 0u; cnt = 0u; mine = 0u;
#pragma nounroll
        for (unsigned j = 0; j < 16; ++j) { const unsigned c = xb_ld(&bar[XB_XCNT(j)]); sum += c; cnt += (c > 0u) ? 1u : 0u; mine = (j == x) ? c : mine; }
        if (sum == G) break;
        __builtin_amdgcn_s_sleep(1);
        if ((++sp & 255u) == 0u) { if (xb_ld(&bar[XB_TMO])) break; if (sp > XB_SPIN_CAP) { atomicAdd(&bar[XB_TMO], 1u); break; } }
    }
    nloc = mine > 0u ? mine : 1u; nx = cnt > 0u ? cnt : 1u;
}
__device__ __forceinline__ void xcd_barrier(const XcdBarrier& b) {
    asm volatile("s_waitcnt vmcnt(0)" ::: "memory");
    __syncthreads();
    if (threadIdx.x == 0) {
        unsigned* bar = b.bar; asm volatile("" : "+s"(bar));
        __builtin_amdgcn_s_waitcnt(0);
        unsigned nloc = b.st[0], nx = b.st[1];
        if (nloc == 0u) { xcd_barrier_complete(bar, b.x, nloc, nx); b.st[0] = nloc; b.st[1] = nx; }
        const unsigned old = xb_add(&bar[XB_XSUB(b.x)], 1u);
        const unsigned gen = old / nloc;
        if (old + 1u == (gen + 1u) * nloc) {
            __builtin_amdgcn_fence(__ATOMIC_RELEASE, "agent");
            asm volatile("s_waitcnt vmcnt(0)" ::: "memory");
            const unsigned og = xb_add(&bar[XB_TOP], 1u);
            const unsigned tg = og / nx;
            if (og + 1u == (tg + 1u) * nx) xb_add(&bar[XB_TOPGEN], 1u);
            else XB_SPIN(xb_ld(&bar[XB_TOPGEN]) == tg, bar);
            __builtin_amdgcn_fence(__ATOMIC_ACQUIRE, "agent");
            xb_add(&bar[XB_XGEN(b.x)], 1u);
            asm volatile("s_waitcnt vmcnt(0)" ::: "memory");
        } else {
            XB_SPIN(xb_ld(&bar[XB_XGEN(b.x)]) == gen, bar);
            __builtin_amdgcn_fence(__ATOMIC_ACQUIRE, "agent");
            asm volatile("s_waitcnt vmcnt(0)" ::: "memory");
        }
    }
    __syncthreads();
}
struct Frame {
    LAS unsigned char* lds;
    volatile LAS unsigned* MISC;
    gu32* ctl;
    unsigned char* ws;
    const float* in[31];
    float* X;
    int tid, lane, wave;
    int G;
    int gw, NGW;
};
enum { I_X = 0, I_C, I_ADA_W, I_ADA_B, I_NPRE, I_NPOST, I_AWIN, I_ALNG, I_ALNB, I_AWS, I_ABS, I_AWOUT, I_KVG, I_KVADAW, I_KVADAB, I_WKV, I_CPOS, I_CW1, I_CB1, I_CW2, I_CB2,
       I_BWIN, I_BWOUT, I_FG, I_FU, I_FD, I_MR, I_MRB, I_MG, I_MU, I_MD, N_IN };

struct TItem { const float* W; bf16* WT; int K, ldn, nvalid, n0, drow0, k0, pitch; float f8scale; };
__device__ __forceinline__ void p0_item_load(const TItem& t, f32x4 (&v)[8], int lane) {
    const int kr = lane >> 3, c4 = (lane & 7) * 4;
#pragma unroll
    for (int i = 0; i < 8; ++i) {
        const int kk = i * 8 + kr; const int n = t.n0 + c4;
        if (n + 3 < t.nvalid) v[i] = *(const GAS f32x4*)(t.W + (size_t)(t.k0 + kk) * t.ldn + n);
        else { const float* p = t.W + (size_t)(t.k0 + kk) * t.ldn; v[i].x = n < t.nvalid ? p[n] : 0.f; v[i].y = n + 1 < t.nvalid ? p[n + 1] : 0.f; v[i].z = n + 2 < t.nvalid ? p[n + 2] : 0.f; v[i].w = 0.f; }
    }
}
__device__ __forceinline__ void p0_item_finish(const TItem& t, const f32x4 (&v)[8], LAS float* scr, int lane) {
    const int kr = lane >> 3, c4 = (lane & 7) * 4;
#pragma unroll
    for (int i = 0; i < 8; ++i) { const int kk = i * 8 + kr; LAS float* s = scr + kk * 33 + c4; s[0] = v[i].x; s[1] = v[i].y; s[2] = v[i].z; s[3] = v[i].w; }
    LDS_WAIT(); asm volatile("" ::: "memory");
    if (t.f8scale != 0.f) {
        const int c = lane & 3; const float sc = t.f8scale;
#pragma unroll
        for (int j = 0; j < 2; ++j) { const int n = (lane >> 2) + 16 * j; const LAS float* s = scr + (16 * c) * 33 + n;
            v4u o; o.x = pg8::pk4_fp8(s[0 * 33] * sc, s[1 * 33] * sc, s[2 * 33] * sc, s[3 * 33] * sc); o.y = pg8::pk4_fp8(s[4 * 33] * sc, s[5 * 33] * sc, s[6 * 33] * sc, s[7 * 33] * sc);
            o.z = pg8::pk4_fp8(s[8 * 33] * sc, s[9 * 33] * sc, s[10 * 33] * sc, s[11 * 33] * sc); o.w = pg8::pk4_fp8(s[12 * 33] * sc, s[13 * 33] * sc, s[14 * 33] * sc, s[15 * 33] * sc);
            *(GAS v4u*)((unsigned char*)t.WT + (size_t)(t.drow0 + n) * t.pitch + t.k0 + 16 * c) = o; }
    } else {
        const int c = lane & 7;
#pragma unroll
        for (int j = 0; j < 4; ++j) { const int n = (lane >> 3) + 8 * j; const LAS float* s = scr + (8 * c) * 33 + n;
            v4u o; o.x = pk2(s[0 * 33], s[1 * 33]); o.y = pk2(s[2 * 33], s[3 * 33]); o.z = pk2(s[4 * 33], s[5 * 33]); o.w = pk2(s[6 * 33], s[7 * 33]);
            *(GAS v4u*)(t.WT + (size_t)(t.drow0 + n) * t.pitch + t.k0 + 8 * c) = o; }
    }
    LDS_WAIT(); asm volatile("" ::: "memory");
}
struct TJob { const float* src; bf16* dst; int K, ldn, nvalid, ncols, nb, map, pitch; size_t sstride, dstride; int items; float f8scale; };
__device__ __forceinline__ TJob tjob(const Frame& F, int j) {
    TJob t; unsigned char* ws = F.ws; t.map = 0; t.f8scale = 0.f; t.pitch = 0;
    switch (j) {
    case 0: t.src = F.in[I_AWIN]; t.dst = (bf16*)(ws + W_AIN); t.K = 1024; t.ldn = 4096; t.ncols = 4096; t.nb = 2; break;
    case 1: t.src = F.in[I_AWOUT]; t.dst = (bf16*)(ws + W_AOUT); t.K = 2048; t.ldn = 1024; t.ncols = 1024; t.nb = 2; t.pitch = KP2; break;
    case 2: t.src = F.in[I_WKV]; t.dst = (bf16*)(ws + W_KV); t.K = 1024; t.ldn = 1536; t.ncols = 1536; t.nb = 1; break;
    case 3: t.src = F.in[I_CW1]; t.dst = (bf16*)(ws + W_C1); t.K = 2048; t.ldn = 256; t.ncols = 256; t.nb = 2; break;
    case 4: t.src = F.in[I_CW2]; t.dst = (bf16*)(ws + W_C2); t.K = 256; t.ldn = 64; t.ncols = 64; t.nb = 2; break;
    case 5: t.src = F.in[I_BWIN]; t.dst = (bf16*)(ws + W_BIN); t.K = 1024; t.ldn = 1072; t.ncols = NQG; t.nb = 2; break;
    case 6: t.src = F.in[I_BWOUT]; t.dst = (bf16*)(ws + W_BOUT); t.K = 1024; t.ldn = 1024; t.ncols = 1024; t.nb = 2; break;
    case 7: t.src = F.in[I_FG]; t.dst = (bf16*)(ws + W_FGU); t.K = 1024; t.ldn = DFF; t.ncols = DFF; t.nb = 2; t.map = 1; t.f8scale = FFN_F8 ? MOE_SW_GU : 0.f; break;
    case 8: t.src = F.in[I_FU]; t.dst = (bf16*)(ws + W_FGU); t.K = 1024; t.ldn = DFF; t.ncols = DFF; t.nb = 2; t.map = 2; t.f8scale = FFN_F8 ? MOE_SW_GU : 0.f; break;
    case 9: t.src = F.in[I_FD]; t.dst = (bf16*)(ws + W_FD); t.K = DFF; t.ldn = 1024; t.ncols = 1024; t.nb = 2; break;
    case 10: t.src = F.in[I_MG]; t.dst = (bf16*)(ws + W_MGU); t.K = 1024; t.ldn = DEXP; t.ncols = DEXP; t.nb = 16; t.map = 1; t.f8scale = MOE_SW_GU; break;
    case 11: t.src = F.in[I_MU]; t.dst = (bf16*)(ws + W_MGU); t.K = 1024; t.ldn = DEXP; t.ncols = DEXP; t.nb = 16; t.map = 2; t.f8scale = MOE_SW_GU; break;
    default: t.src = F.in[I_MD]; t.dst = (bf16*)(ws + W_MD); t.K = DEXP; t.ldn = 1024; t.ncols = 1024; t.nb = 16; t.f8scale = MOE_SW_D; break;
    }
    t.nvalid = t.ldn;
    if (t.pitch == 0) t.pitch = t.K;
    t.sstride = (size_t)t.K * t.ldn; t.dstride = (size_t)t.pitch * (t.map ? 2 * t.ncols : t.ncols); if (t.f8scale != 0.f) t.dstride >>= 1;
    t.items = t.nb * (t.K / 64) * (t.ncols / 32);
    return t;
}
constexpr int N_TJOBS = 13;
constexpr int GEMV_CHUNKS = MODC / 256;
constexpr int GEMV_TASKS = GEMV_CHUNKS * MODKS;
__device__ __forceinline__ void p0_gemv_task(const Frame& F, int task) {
    const int cc = task / MODKS, ks = task % MODKS;
    const float* W; const float* vec; int ldn, n0, kper; bool act;
    if (cc < 96) { const int mat = cc / 12; W = F.in[I_ADA_W] + (size_t)mat * 1024 * 3072; ldn = 3072; n0 = (cc % 12) * 256; kper = 64; vec = F.in[I_C]; act = true; }
    else if (cc < 104) { W = F.in[I_KVADAW]; ldn = 2048; n0 = (cc - 96) * 256; kper = 64; vec = F.in[I_C]; act = true; }
    else { const int j = cc - 104; W = F.in[I_CW1] + (size_t)j * 2048 * 256; ldn = 256; n0 = 0; kper = 128; vec = F.in[I_CPOS] + j * 2048; act = false; }
    const int k0 = ks * kper;
    f32x4 acc = (f32x4){0.f, 0.f, 0.f, 0.f};
    const float* wp = W + (size_t)k0 * ldn + n0 + 4 * F.lane;
    for (int k = 0; k < kper; k += 8) {
        f32x4 w[8]; float a[8];
#pragma unroll
        for (int u = 0; u < 8; ++u) { w[u] = *(const GAS f32x4*)(wp + (size_t)(k + u) * ldn); a[u] = vec[k0 + k + u]; }
#pragma unroll
        for (int u = 0; u < 8; ++u) { const float av = act ? pg8::silu_f(a[u]) : a[u]; acc += w[u] * av; }
    }
    *(GAS f32x4*)((float*)(F.ws + WS_MODP) + (size_t)ks * MODC + cc * 256 + 4 * F.lane) = acc;
}
__device__ __forceinline__ void p0_prologue(Frame& F) {
    LAS float* scr = (LAS float*)(F.lds + RING_OFF + F.wave * 16384);
    for (int task = F.gw; task < GEMV_TASKS; task += F.NGW) p0_gemv_task(F, task);
    int off = 0;
    for (int j = 0; j < N_TJOBS; ++j) {
        const TJob t = tjob(F, j);
        const int nb32 = t.ncols / 32, per_b = (t.K / 64) * nb32;
        int it = (F.gw - off % F.NGW + F.NGW) % F.NGW;
#define P0_ITEM(ti_, it_) do { const int b_ = (it_) / per_b, r_ = (it_) % per_b, kb_ = r_ / nb32, nb_ = r_ % nb32, n0_ = nb_ * 32; \
            ti_.W = t.src + (size_t)b_ * t.sstride; ti_.WT = t.dst + (size_t)b_ * t.dstride; ti_.f8scale = t.f8scale; ti_.K = t.K; ti_.pitch = t.pitch; ti_.ldn = t.ldn; ti_.nvalid = t.nvalid; ti_.n0 = n0_; ti_.k0 = kb_ * 64; \
            ti_.drow0 = t.map ? ((n0_ >> 7) * 256 + (n0_ & 127) + (t.map == 2 ? 128 : 0)) : n0_; } while (0)
        if (it < t.items) {
            TItem cur; f32x4 vc[8]; P0_ITEM(cur, it); p0_item_load(cur, vc, F.lane);
            for (;;) {
                const int itn = it + F.NGW; const bool more = itn < t.items;
                TItem nxt = cur; f32x4 vn[8];
                if (more) { P0_ITEM(nxt, itn); p0_item_load(nxt, vn, F.lane); }
                p0_item_finish(cur, vc, scr, F.lane);
                if (!more) break;
                cur = nxt; it = itn;
#pragma unroll
                for (int i = 0; i < 8; ++i) vc[i] = vn[i];
            }
        }
#undef P0_ITEM
        off += t.items;
    }
}

__device__ __forceinline__ void moe_offsets(const Frame& F, int jm, int (&pstart)[8], int (&pend_t)[8]) {
    int acc = 0;
#pragma unroll
    for (int e = 0; e < 8; ++e) { const int c = (int)__hip_atomic_load(F.ctl + CW_MOE + jm * 1024 + 64 * e, RLX_AGENT); pstart[e] = acc; acc += (c + MOE_BLK - 1) / MOE_BLK * MOE_BLK; pend_t[e] = acc / MOE_BLK; }
#pragma unroll
    for (int e = 0; e < 8; ++e) { pstart[e] = __builtin_amdgcn_readfirstlane(pstart[e]); pend_t[e] = __builtin_amdgcn_readfirstlane(pend_t[e]); }
}
__device__ __forceinline__ float modsum(const Frame& F, int cc) {
    const float* mp = (const float*)(F.ws + WS_MODP) + cc; float s = 0.f;
#pragma unroll
    for (int k = 0; k < MODKS; ++k) s += mp[(size_t)k * MODC];
    return s;
}
template <int SRC_IN, int POST, int PRE, int KVPRE, int ROUTER, int H8 = ROUTER>
__device__ __forceinline__ void thin_phase(Frame& F, int lp, int sp, int lq, int sq, int jm_post, int jm_router) {
    LAS float* V = (LAS float*)(F.lds + RING_OFF);
    LAS float* WR = (LAS float*)(F.lds + RING_OFF + 32768);
    LAS unsigned* RS = (LAS unsigned*)(F.lds + SLC_BM_OFF);
    LAS unsigned char* H8L = F.lds + RING_OFF + 65536;
    const float* MODF = (const float*)(F.ws + WS_MOD);
#define MODV(cc_, bias_) (SRC_IN ? (modsum(F, (cc_)) + (bias_)) : MODF[(cc_)])
    if (SRC_IN) {
        for (int cc = blockIdx.x * NWAVES * 64 + F.tid; cc < 8 * 3072 + 2048; cc += F.G * NWAVES * 64)
            ((float*)(F.ws + WS_MOD))[cc] = modsum(F, cc) + (cc < 8 * 3072 ? F.in[I_ADA_B][cc] : F.in[I_KVADAB][cc - 8 * 3072]);
    }
    for (int i = F.tid; i < 1024; i += NWAVES * 64) {
        if (POST) { const int ms = lp * 2 + sp; V[0 * 1024 + i] = MODV(ms * 3072 + 2048 + i, F.in[I_ADA_B][ms * 3072 + 2048 + i]); V[1 * 1024 + i] = F.in[I_NPOST][ms * 1024 + i]; }
        if (PRE) { const int ms = lq * 2 + sq; V[2 * 1024 + i] = F.in[I_NPRE][ms * 1024 + i];
            V[3 * 1024 + i] = 1.0f + MODV(ms * 3072 + 1024 + i, F.in[I_ADA_B][ms * 3072 + 1024 + i]);
            V[4 * 1024 + i] = MODV(ms * 3072 + i, F.in[I_ADA_B][ms * 3072 + i]); }
        if (KVPRE) { V[5 * 1024 + i] = F.in[I_KVG][i]; V[6 * 1024 + i] = 1.0f + MODV(24576 + 1024 + i, F.in[I_KVADAB][1024 + i]); V[7 * 1024 + i] = MODV(24576 + i, F.in[I_KVADAB][i]); }
    }
    if (ROUTER) { for (int i = F.tid; i < 8192; i += NWAVES * 64) WR[i] = F.in[I_MR][(size_t)jm_router * 8192 + i]; if (F.tid < 16) RS[F.tid] = 0u; }
    if (SRC_IN && F.gw == 0 && !POST) {
        for (int i = F.lane; i < 512; i += 64) ((float*)(F.ws + WS_CB1))[i] = modsum(F, 26624 + i) + F.in[I_CB1][i];
    }
    __syncthreads();
    int cps[8], cpe[8]; int early_rows = 0; if (POST == 2) { moe_offsets(F, jm_post, cps, cpe); early_rows = (M3_SPLIT ? 0 : moe_early_tiles(cpe[7], F.G)) * 64; } else {
#pragma unroll
        for (int e = 0; e < 8; ++e) { cps[e] = 0; cpe[e] = 0; } }
    const float* xsrc = F.in[I_X]; bf16* X16 = (bf16*)(F.ws + WS_X16);
    const bf16* YB3 = (const bf16*)(F.ws + WS_XBUF2);
    const bf16* Yb = (const bf16*)(F.ws + WS_Y);
    const bf16* YB2 = (const bf16*)(F.ws + WS_YBUF);
    const unsigned* ROUTE = (const unsigned*)(F.ws + WS_ROUTE);
    int itn = 0;
    constexpr int PD = (POST == 2) ? 2 : 4, PY = (POST == 2) ? 1 : PD;
    f32x4 bxf[PD][4]; v2u bxh[PD][4], bya[PY][4], byb[PY][4], byc[PY][4], byd[PY][4]; unsigned rt[2][6];
#define THIN_LOAD(row_, d_) do { \
        if (SRC_IN) { _Pragma("unroll") for (int j = 0; j < 4; ++j) bxf[d_][j] = *(const GAS f32x4*)(xsrc + (size_t)(row_) * D + 4 * F.lane + 256 * j); } \
        else { _Pragma("unroll") for (int j = 0; j < 4; ++j) bxh[d_][j] = *(const GAS v2u*)(X16 + (size_t)(row_) * D + 4 * F.lane + 256 * j); } \
        if (POST == 1) { _Pragma("unroll") for (int j = 0; j < 4; ++j) bya[d_][j] = *(const GAS v2u*)(Yb + (size_t)(row_) * D + 4 * F.lane + 256 * j); } \
        } while (0)
#define THIN_ROUTE(row_, d_) do { _Pragma("unroll") for (int q_ = 0; q_ < 6; ++q_) rt[d_][q_] = ROUTE[(size_t)(row_) * 8 + q_]; } while (0)
#define THIN_YLOAD(d_) do { unsigned s1_ = rt[d_][2], s2_ = rt[d_][3]; \
        _Pragma("unroll") for (int e = 0; e < 8; ++e) { if ((int)rt[d_][0] == e) s1_ += (unsigned)cps[e]; if ((int)rt[d_][1] == e) s2_ += (unsigned)cps[e]; }     \
        const bf16* r1_ = (int)s1_ < early_rows ? YB2 : YB3; const bf16* r2_ = (int)s2_ < early_rows ? YB2 : YB3;     \
        _Pragma("unroll") for (int j = 0; j < 4; ++j) { if (M3_SPLIT) { bya[0][j] = *(const GAS v2u*)(YB2 + (size_t)s1_ * D + 4 * F.lane + 256 * j); byb[0][j] = *(const GAS v2u*)(YB2 + (size_t)s2_ * D + 4 * F.lane + 256 * j); } else { bya[0][j] = (v2u){0u, 0u}; byb[0][j] = (v2u){0u, 0u}; } \
            byc[0][j] = *(const GAS v2u*)(r1_ + (size_t)s1_ * D + 4 * F.lane + 256 * j); byd[0][j] = *(const GAS v2u*)(r2_ + (size_t)s2_ * D + 4 * F.lane + 256 * j); } } while (0)
#pragma unroll
    for (int d = 0; d < PD; ++d) {
#pragma unroll
        for (int j = 0; j < 4; ++j) { bxf[d][j] = (f32x4){0.f, 0.f, 0.f, 0.f}; bxh[d][j] = (v2u){0u, 0u}; if (d < PY) { bya[d][j] = (v2u){0u, 0u}; byb[d][j] = (v2u){0u, 0u}; byc[d][j] = (v2u){0u, 0u}; byd[d][j] = (v2u){0u, 0u}; } }
    }
#pragma unroll
    for (int q = 0; q < 6; ++q) { rt[0][q] = 0u; rt[1][q] = 0u; }
    if (POST == 2) {
        if (F.gw < M) { THIN_ROUTE(F.gw, 0); THIN_YLOAD(0); THIN_LOAD(F.gw, 0); }
        if (F.gw + F.NGW < M) THIN_ROUTE(F.gw + F.NGW, 1);
    } else {
#pragma unroll
        for (int d = 0; d < PD; ++d) if (F.gw + d * F.NGW < M) THIN_LOAD(F.gw + d * F.NGW, d);
    }
    for (int row0 = F.gw; row0 < M; row0 += PD * F.NGW) {
#pragma unroll
      for (int d = 0; d < PD; ++d) {
        const int row = row0 + d * F.NGW;
        if (row < M) {
        f32x4 x[4], y[4]; v2u ya[4];
#pragma unroll
        for (int j = 0; j < 4; ++j) { if (SRC_IN) x[j] = bxf[d][j]; else { const v2u xw_ = bxh[d][j]; x[j] = (f32x4){bf_lo(xw_.x), bf_hi(xw_.x), bf_lo(xw_.y), bf_hi(xw_.y)}; }
            ya[j] = bya[POST == 2 ? 0 : d][j]; y[j] = (f32x4){0.f, 0.f, 0.f, 0.f}; }
        if (POST == 2) {
            const float g1 = __builtin_bit_cast(float, rt[d][4]), g2 = __builtin_bit_cast(float, rt[d][5]);
#pragma unroll
            for (int j = 0; j < 4; ++j) { const v2u w = bya[0][j], z = byb[0][j], w2 = byc[0][j], z2 = byd[0][j];
                y[j] = ((f32x4){bf_lo(w.x), bf_hi(w.x), bf_lo(w.y), bf_hi(w.y)} + (f32x4){bf_lo(w2.x), bf_hi(w2.x), bf_lo(w2.y), bf_hi(w2.y)}) * g1
                     + ((f32x4){bf_lo(z.x), bf_hi(z.x), bf_lo(z.y), bf_hi(z.y)} + (f32x4){bf_lo(z2.x), bf_hi(z2.x), bf_lo(z2.y), bf_hi(z2.y)}) * g2; }
            asm volatile("" :: "v"(y[0]), "v"(y[1]), "v"(y[2]), "v"(y[3]));
            if (row + F.NGW < M) { THIN_YLOAD(d ^ 1); THIN_LOAD(row + F.NGW, d ^ 1); }
            if (row + 2 * F.NGW < M) THIN_ROUTE(row + 2 * F.NGW, d);
        } else {
            if (row + PD * F.NGW < M) THIN_LOAD(row + PD * F.NGW, d);
        }
        if (POST) {
            if (POST == 1) {
#pragma unroll
                for (int j = 0; j < 4; ++j) { const v2u w = ya[j]; y[j] = (f32x4){bf_lo(w.x), bf_hi(w.x), bf_lo(w.y), bf_hi(w.y)}; }
            }
            float ss = 0.f;
#pragma unroll
            for (int j = 0; j < 4; ++j) ss += (y[j].x * y[j].x + y[j].y * y[j].y) + (y[j].z * y[j].z + y[j].w * y[j].w);
            const float rs = 1.0f / sqrtf(wave_sum(ss) * (1.0f / D) + EPS);
#pragma unroll
            for (int j = 0; j < 4; ++j) { const f32x4 gt = *(const LAS f32x4*)(V + 0 * 1024 + 4 * F.lane + 256 * j), gp = *(const LAS f32x4*)(V + 1 * 1024 + 4 * F.lane + 256 * j);
                x[j] = x[j] + gt * (y[j] * rs * gp); }
        }
        if (POST || SRC_IN) {
            if (!PRE && !KVPRE) {
#pragma unroll
                for (int j = 0; j < 4; ++j) *(GAS f32x4*)(F.X + (size_t)row * D + 4 * F.lane + 256 * j) = x[j];
            } else {
#pragma unroll
                for (int j = 0; j < 4; ++j) { v2u w; w.x = pk2(x[j].x, x[j].y); w.y = pk2(x[j].z, x[j].w); *(GAS v2u*)(X16 + (size_t)row * D + 4 * F.lane + 256 * j) = w; }
            }
        }
        if (PRE || KVPRE) {
            float ss = 0.f;
#pragma unroll
            for (int j = 0; j < 4; ++j) ss += (x[j].x * x[j].x + x[j].y * x[j].y) + (x[j].z * x[j].z + x[j].w * x[j].w);
            const float rs = 1.0f / sqrtf(wave_sum(ss) * (1.0f / D) + EPS);
            f32x4 h[4];
            if (PRE) {
#pragma unroll
                for (int j = 0; j < 4; ++j) { const f32x4 gp = *(const LAS f32x4*)(V + 2 * 1024 + 4 * F.lane + 256 * j), sc = *(const LAS f32x4*)(V + 3 * 1024 + 4 * F.lane + 256 * j), sh = *(const LAS f32x4*)(V + 4 * 1024 + 4 * F.lane + 256 * j);
                    h[j] = (x[j] * rs * gp) * sc + sh;
                    if (H8 && ROUTER) *(LAS unsigned*)(H8L + (F.wave * 8 + itn) * 1024 + 4 * F.lane + 256 * j) = pg8::pk4_fp8(h[j].x, h[j].y, h[j].z, h[j].w);
                    else if (H8) *(GAS unsigned*)((unsigned char*)(F.ws + WS_H) + (size_t)row * D + 4 * F.lane + 256 * j) = pg8::pk4_fp8(h[j].x, h[j].y, h[j].z, h[j].w);
                    else { v2u w; w.x = pk2(h[j].x, h[j].y); w.y = pk2(h[j].z, h[j].w); *(GAS v2u*)((bf16*)(F.ws + WS_H) + (size_t)row * D + 4 * F.lane + 256 * j) = w; } }
            }
            if (KVPRE) {
#pragma unroll
                for (int j = 0; j < 4; ++j) { const f32x4 gp = *(const LAS f32x4*)(V + 5 * 1024 + 4 * F.lane + 256 * j), sc = *(const LAS f32x4*)(V + 6 * 1024 + 4 * F.lane + 256 * j), sh = *(const LAS f32x4*)(V + 7 * 1024 + 4 * F.lane + 256 * j);
                    const f32x4 hk = (x[j] * rs * gp) * sc + sh;
                    v2u w; w.x = pk2(hk.x, hk.y); w.y = pk2(hk.z, hk.w); *(GAS v2u*)((bf16*)(F.ws + WS_HKV) + (size_t)row * D + 4 * F.lane + 256 * j) = w; }
            }
            if (ROUTER) {
                float lg[8];
#pragma unroll
                for (int e = 0; e < 8; ++e) lg[e] = 0.f;
#pragma unroll
                for (int j = 0; j < 4; ++j)
#pragma unroll
                    for (int i = 0; i < 4; ++i) { const int k = 4 * F.lane + 256 * j + i; const f32x4 w0 = *(const LAS f32x4*)(WR + k * 8), w1 = *(const LAS f32x4*)(WR + k * 8 + 4); const float hv = h[j][i];
                        lg[0] += hv * w0.x; lg[1] += hv * w0.y; lg[2] += hv * w0.z; lg[3] += hv * w0.w; lg[4] += hv * w1.x; lg[5] += hv * w1.y; lg[6] += hv * w1.z; lg[7] += hv * w1.w; }
#pragma unroll
                for (int e = 0; e < 8; ++e) lg[e] = wave_sum(lg[e]) + F.in[I_MRB][jm_router * 8 + e];
                int e1 = 0; float v1 = lg[0];
#pragma unroll
                for (int e = 1; e < 8; ++e) if (lg[e] > v1) { v1 = lg[e]; e1 = e; }
                int e2 = -1; float v2 = -3.0e38f;
#pragma unroll
                for (int e = 0; e < 8; ++e) if (e != e1 && lg[e] > v2) { v2 = lg[e]; e2 = e; }
                const float ex = __expf(v2 - v1); const float rg1 = 1.0f / (1.0f + ex), rg2 = ex / (1.0f + ex);
                if (F.lane == 0) {
                    const unsigned r1 = atomicAdd((unsigned*)&RS[e1], 1u), r2 = atomicAdd((unsigned*)&RS[e2], 1u);
                    LAS unsigned* rec = RS + 16 + 8 * (F.wave * 8 + itn);
                    rec[0] = (unsigned)e1; rec[1] = (unsigned)e2; rec[2] = r1; rec[3] = r2; rec[4] = __builtin_bit_cast(unsigned, rg1); rec[5] = __builtin_bit_cast(unsigned, rg2);
                }
            }
        }
        ++itn;
        }
      }
    }
#undef THIN_LOAD
#undef THIN_ROUTE
#undef THIN_YLOAD
#undef MODV
    if (ROUTER) {
        __syncthreads();
        if (F.tid < 8) RS[8 + F.tid] = __hip_atomic_fetch_add(F.ctl + CW_MOE + jm_router * 1024 + 64 * F.tid, RS[F.tid], RLX_AGENT);
        __syncthreads();
        int it2 = 0;
        for (int row = F.gw; row < M; row += F.NGW, ++it2) {
            const LAS unsigned* rec = RS + 16 + 8 * (F.wave * 8 + it2);
            const unsigned e1 = rec[0], e2 = rec[1], p1 = RS[8 + e1] + rec[2], p2 = RS[8 + e2] + rec[3];
            const v4u hv = *(const LAS v4u*)(H8L + (F.wave * 8 + it2) * 1024 + 16 * F.lane);
            unsigned char* XB = (unsigned char*)(F.ws + WS_XBUF);
            *(GAS v4u*)(XB + ((size_t)e1 * 16384 + p1) * D + 16 * F.lane) = hv; *(GAS v4u*)(XB + ((size_t)e2 * 16384 + p2) * D + 16 * F.lane) = hv;
            if (F.lane == 0) { unsigned* o = (unsigned*)(F.ws + WS_ROUTE) + (size_t)row * 8; o[0] = e1; o[1] = e2; o[2] = p1; o[3] = p2; o[4] = rec[4]; o[5] = rec[5]; }
        }
    }
}

template <int MODE = 0> struct MoeOrderT {
    int nM, nN, G, c; int pend_t[8]; size_t estride; int ksplit; size_t khalf_bytes; int afixed;
    int early = 0;
    __device__ __forceinline__ bool next(int i, pg8::Unit& u) const {
        if (MODE == 1 && early > 0) { const int U = nM * nN, R0 = (U >> 8) - 2, Gn = 256 - early;
            if (i < R0) return pg8::tile_from_L((long)(i * 256 + c), nM, nN, u);
            if (c >= Gn) return false;
            return pg8::tile_from_L((long)(R0 * 256 + (i - R0) * Gn + c), nM, nN, u); }
        if (MODE == 2) { const int po = early >> 2; if (!pg8::tile_from_L((long)i * G + c, nM - po, nN, u)) return false; u.pm += po; return true; }
        if (MODE == 3) { const int e = c - (256 - early); if (i > 0 || e < 0) return false; u.pm = e >> 2; u.pn = e & 3; return true; }
        return pg8::tile_order(i, G, c, nM, nN, u); }
    __device__ __forceinline__ const char* a_ptr(const pg8::Gemm& g, const pg8::Unit& u) const {
        if (afixed) { int e = 0, t0 = 0;
#pragma unroll
            for (int k = 0; k < 7; ++k) { const bool ge = u.pm >= pend_t[k]; e += ge ? 1 : 0; t0 = ge ? pend_t[k] : t0; }
            return g.A + ((size_t)e * 16384 + (size_t)(u.pm - t0) * pg8::BM) * ((size_t)g.lda * 2); }
        return g.A + (size_t)u.pm * ((size_t)pg8::BM * g.lda * 2) + ((ksplit && u.pn >= (nN >> 1)) ? khalf_bytes : (size_t)0); }
    __device__ __forceinline__ const char* b_ptr(const pg8::Gemm& g, const pg8::Unit& u) const {
        int e = 0;
#pragma unroll
        for (int k = 0; k < 7; ++k) e += (u.pm >= pend_t[k]) ? 1 : 0;
        const bool hi = ksplit && u.pn >= (nN >> 1); const int pn = hi ? u.pn - (nN >> 1) : u.pn;
        return g.Bt + (size_t)e * estride + (size_t)pn * ((size_t)pg8::BM * g.ldb * 2) + (hi ? khalf_bytes : (size_t)0);
    }
};
typedef MoeOrderT<0> MoeOrder;
__device__ __forceinline__ bf16x4 tr_read(unsigned addr) { bf16x4 r; asm volatile("ds_read_b64_tr_b16 %0, %1\n\ts_waitcnt lgkmcnt(0)" : "=&v"(r) : "v"(addr) : "memory"); return r; }
__device__ __forceinline__ void spatial_phase(Frame& F, int l) {
    LAS float* stats = (LAS float*)(F.lds + RING_OFF);
    LAS float* c1 = (LAS float*)(F.lds + RING_OFF + 1024);
    LAS float* c2 = (LAS float*)(F.lds + RING_OFF + 1536);
    LAS float* bsv = (LAS float*)(F.lds + RING_OFF + 2048);
    LAS unsigned char* Wp = F.lds + RING_OFF + 4096;
    LAS unsigned char* Vt = F.lds + RING_OFF + 40960;
    LAS float* lgl = (LAS float*)(F.lds + RING_OFF + 110592);
    const bf16* Ub = (const bf16*)(F.ws + WS_U); const bf16* Vb = (const bf16*)(F.ws + WS_V); bf16* UMb = (bf16*)(F.ws + WS_UM);
    const int lane = F.lane, fr = lane & 15, fq = lane >> 4;
    for (int unit = blockIdx.x; unit < 256; unit += F.G) {
        const int c = unit >> 1, hf = unit & 1;
#pragma nounroll
        for (int ib = 0; ib < 4; ++ib) {
            v4u wv[4][4];
#pragma unroll
            for (int i = 0; i < 4; ++i) { const bf16* vr = Vb + (size_t)(c * 128 + F.wave * 16 + 4 * ib + i) * 2048;
#pragma unroll
                for (int j = 0; j < 4; ++j) wv[i][j] = *(const GAS v4u*)(vr + 8 * lane + 512 * j); }
#pragma unroll
            for (int i = 0; i < 4; ++i) {
                const int r = F.wave * 16 + 4 * ib + i; float s = 0.f, ss = 0.f;
#pragma unroll
                for (int j = 0; j < 4; ++j) { const v4u w = wv[i][j];
                    const float a0 = bf_lo(w.x), a1 = bf_hi(w.x), a2 = bf_lo(w.y), a3 = bf_hi(w.y), a4 = bf_lo(w.z), a5 = bf_hi(w.z), a6 = bf_lo(w.w), a7 = bf_hi(w.w);
                    s += ((a0 + a1) + (a2 + a3)) + ((a4 + a5) + (a6 + a7)); ss += ((a0 * a0 + a1 * a1) + (a2 * a2 + a3 * a3)) + ((a4 * a4 + a5 * a5) + (a6 * a6 + a7 * a7)); }
                s = wave_sum(s); ss = wave_sum(ss);
                const float mean = s * (1.0f / 2048.0f); float var = ss * (1.0f / 2048.0f) - mean * mean; var = var > 0.f ? var : 0.f;
                if (lane == 0) { stats[r * 2] = mean; stats[r * 2 + 1] = 1.0f / sqrtf(var + EPS); }
            }
        }
        __syncthreads();
#pragma nounroll
        for (int gi = 0; gi < 4; ++gi) {
            const int g = hf * 4 + gi;
            const float* Wg = F.in[I_AWS] + (size_t)(l * 8 + g) * 128 * 128;
            int tq = F.tid; asm volatile("" : "+v"(tq));
            v4u vtl[8], utl[8];
#pragma unroll
            for (int i = 0; i < 8; ++i) { const int p = i * 512 + tq, s = p >> 5, ch = p & 31; vtl[i] = *(const GAS v4u*)((const GAS char*)Vb + (size_t)c * 524288 + (size_t)g * 512 + (unsigned)((s * 2048 + ch * 8) * 2)); }
#pragma unroll
            for (int i = 0; i < 8; ++i) { const int p = i * 512 + tq, s = p >> 5, ch = p & 31; utl[i] = *(const GAS v4u*)((const GAS char*)Ub + (size_t)c * 524288 + (size_t)g * 512 + (unsigned)((s * 2048 + ch * 8) * 2)); }
            const float lgr = (F.tid < 256 ? F.in[I_ALNG] : F.in[I_ALNB])[l * 2048 + g * 256 + (F.tid & 255)];
            const float bsr = F.tid < 128 ? F.in[I_ABS][(l * 8 + g) * 128 + (F.tid & 127)] : 0.f;
            const float rs0 = stats[lane * 2 + 1], rs1 = stats[(lane + 64) * 2 + 1], mu0 = stats[lane * 2], mu1 = stats[(lane + 64) * 2];
#pragma nounroll
            for (int ib = 0; ib < 2; ++ib) {
            float wl[8][2];
#pragma unroll
            for (int i = 0; i < 8; ++i) { wl[i][0] = Wg[(F.wave * 16 + 8 * ib + i) * 128 + lane]; wl[i][1] = Wg[(F.wave * 16 + 8 * ib + i) * 128 + lane + 64]; }
#pragma unroll
            for (int i8 = 0; i8 < 8; ++i8) {
                const int i = i8, t = F.wave * 16 + 8 * ib + i8; float a1 = 0.f, a2 = 0.f;
#pragma unroll
                for (int h2 = 0; h2 < 2; ++h2) { const int s = lane + 64 * h2; const float w = wl[i][h2]; const float wv = s <= t ? w : 0.f; const float p = wv * (h2 ? rs1 : rs0);
                    *(LAS unsigned short*)(Wp + t * 272 + s * 2) = (unsigned short)pk2(p, 0.f); a1 += p * (h2 ? mu1 : mu0); a2 += wv; }
                a1 = wave_sum(a1); a2 = wave_sum(a2);
                if (lane == 0) { c1[t] = a1; c2[t] = a2; }
            }
            }
#pragma unroll
            for (int i = 0; i < 8; ++i) { const int p = i * 512 + tq, s = p >> 5, ch = p & 31; *(LAS v4u*)(Vt + s * 528 + ch * 16) = vtl[i]; }
            if (F.tid < 128) bsv[F.tid] = bsr;
            lgl[F.tid] = lgr;
            __syncthreads();
            f32x4 acc[2][8];
#pragma unroll
            for (int a = 0; a < 2; ++a)
#pragma unroll
                for (int b = 0; b < 8; ++b) acc[a][b] = (f32x4){0.f, 0.f, 0.f, 0.f};
            const int q = (lane & 15) >> 2, p4 = lane & 3;
#pragma unroll
            for (int dt2 = 0; dt2 < 2; ++dt2) {
                const int dt = F.wave * 2 + dt2;
#pragma unroll
                for (int ks = 0; ks < 4; ++ks) {
                    LAS unsigned char* a0 = Vt + (32 * ks + 8 * fq + q) * 528 + (16 * dt + 4 * p4) * 2;
                    const bf16x4 lo = __builtin_amdgcn_ds_read_tr16_b64_v4i16((LAS bf16x4*)a0), hi = __builtin_amdgcn_ds_read_tr16_b64_v4i16((LAS bf16x4*)(a0 + 4 * 528));
                    bf16x8 af; af[0] = lo[0]; af[1] = lo[1]; af[2] = lo[2]; af[3] = lo[3]; af[4] = hi[0]; af[5] = hi[1]; af[6] = hi[2]; af[7] = hi[3];
#pragma unroll
                    for (int tt = 2 * ks; tt < 8; ++tt) {
                        const bf16x8 bfr = *(const LAS bf16x8*)(Wp + (16 * tt + fr) * 272 + (32 * ks + 8 * fq) * 2);
                        acc[dt2][tt] = __builtin_amdgcn_mfma_f32_16x16x32_bf16(af, bfr, acc[dt2][tt], 0, 0, 0);
                    }
                }
            }
            __syncthreads();
#pragma unroll
            for (int i = 0; i < 8; ++i) { const int p = i * 512 + tq, s = p >> 5, ch = p & 31; *(LAS v4u*)(Vt + s * 528 + ch * 16) = utl[i]; }
            __syncthreads();
#pragma unroll
            for (int dt2 = 0; dt2 < 2; ++dt2) {
                const int frq = tq & 15, fqq = (tq >> 4) & 3; const int dl = 16 * (F.wave * 2 + dt2) + 4 * fqq;
                const f32x4 lg = *(const LAS f32x4*)(lgl + dl), lb = *(const LAS f32x4*)(lgl + 256 + dl);
#pragma unroll
                for (int tt = 0; tt < 8; ++tt) {
                    const int t = 16 * tt + frq;
                    const float c1t = c1[t], c2t = c2[t], bst = bsv[t];
                    LAS v2u* up = (LAS v2u*)(Vt + t * 528 + dl * 2);
                    const v2u uw = *up;
                    const f32x4 uu = (f32x4){bf_lo(uw.x), bf_hi(uw.x), bf_lo(uw.y), bf_hi(uw.y)};
                    const f32x4 mixed = lg * (acc[dt2][tt] - c1t) + lb * c2t + bst;
                    const f32x4 o = uu * mixed;
                    v2u w; w.x = pk2(o.x, o.y); w.y = pk2(o.z, o.w); *up = w;
                }
            }
            __syncthreads();
#pragma unroll
            for (int i = 0; i < 8; ++i) { const int p = i * 512 + tq, s = p >> 5, ch = p & 31;
                const v4u w = *(const LAS v4u*)(Vt + s * 528 + ch * 16); *(GAS v4u*)((GAS char*)UMb + (size_t)c * (128 * KP2 * 2) + (size_t)g * 512 + (unsigned)((s * KP2 + ch * 8) * 2)) = w; }
            __syncthreads();
        }
    }
}

struct CmpOrder {
    int G, c;
    __device__ __forceinline__ bool next(int i, pg8::Unit& u) const { const int L = i * G + c; if (L >= 32) return false; u.pm = L; u.pn = 0; return true; }
    __device__ __forceinline__ const char* a_ptr(const pg8::Gemm& g, const pg8::Unit& u) const { const int jg = u.pm >> 2, nt = u.pm & 3, j = jg >> 2, gg = jg & 3;
        return g.A + (size_t)(j * 256 + gg * 64) * 2 + (size_t)nt * ((size_t)256 * g.lda * 2); }
    __device__ __forceinline__ const char* b_ptr(const pg8::Gemm& g, const pg8::Unit& u) const { return g.Bt + (size_t)(u.pm >> 4) * ((size_t)256 * 2048 * 2); }
};
template <int PART  >
__device__ __forceinline__ void cmp2_vt_phase(Frame& F, int w0, int nw, int t_lo = 0, int t_hi = 512) {
    const int lane = F.lane, fr = lane & 15, fq = lane >> 4;
    const bf16* HID = (const bf16*)(F.ws + WS_HID);
    const bf16* KVb = (const bf16*)(F.ws + WS_KV);
    bf16* KC = (bf16*)(F.ws + WS_KCMP); bf16* VCT = (bf16*)(F.ws + WS_VCMPT); bf16* VT = (bf16*)(F.ws + WS_VT);
    LAS unsigned char* scr = F.lds + RING_OFF + F.wave * 16384;
    for (int task = (PART == 0 ? t_lo : 512) + w0; task < (PART == 0 ? t_hi : 512 + 2048 + 1024); task += nw) {
        if (task >= 512 + 2048) {
            const int tt = task - 2560, g = tt >> 8, key = (tt & 255) * 64 + lane;
#pragma unroll
            for (int br = 0; br < 2; ++br) {
                const bf16* kr = KVb + (size_t)key * 1536 + (br ? 1024 : 512) + g * 64; float ss = 0.f;
#pragma unroll
                for (int i = 0; i < 8; ++i) { const v4u kw = *(const GAS v4u*)(kr + 8 * i);
                    ss += (bf_lo(kw.x) * bf_lo(kw.x) + bf_hi(kw.x) * bf_hi(kw.x)) + (bf_lo(kw.y) * bf_lo(kw.y) + bf_hi(kw.y) * bf_hi(kw.y)) + (bf_lo(kw.z) * bf_lo(kw.z) + bf_hi(kw.z) * bf_hi(kw.z)) + (bf_lo(kw.w) * bf_lo(kw.w) + bf_hi(kw.w) * bf_hi(kw.w)); }
#pragma unroll
                for (int o = 1; o < 64; o <<= 1) ss = fmaxf(ss, shx(ss, lane, o));
                if (lane == 0) __hip_atomic_fetch_max(F.ctl + CW_KMAX + 256 * br + 64 * g, __builtin_bit_cast(unsigned, ss), RLX_AGENT);
            }
        } else if (task < 512) {
            const int rt = task, j = rt >> 8, g = (rt & 255) >> 6, n0 = (rt & 63) * 16;
            const bf16* w2t = (const bf16*)(F.ws + W_C2) + (size_t)j * 64 * 256;
            f32x4 acc[4];
#pragma unroll
            for (int dt = 0; dt < 4; ++dt) acc[dt] = (f32x4){0.f, 0.f, 0.f, 0.f};
#pragma unroll
            for (int ks = 0; ks < 8; ++ks) {
                const bf16x8 hf = *(const GAS bf16x8*)(HID + (size_t)(16 * rt + fr) * 256 + 32 * ks + 8 * fq);
#pragma unroll
                for (int dt = 0; dt < 4; ++dt) {
                    const bf16x8 wf = *(const GAS bf16x8*)(w2t + (size_t)(16 * dt + fr) * 256 + 32 * ks + 8 * fq);
                    if (j == 0) acc[dt] = __builtin_amdgcn_mfma_f32_16x16x32_bf16(wf, hf, acc[dt], 0, 0, 0);
                    else        acc[dt] = __builtin_amdgcn_mfma_f32_16x16x32_bf16(hf, wf, acc[dt], 0, 0, 0);
                }
            }
            float kss = 0.f;
#pragma unroll
            for (int dt = 0; dt < 4; ++dt) {
                if (j == 0) {
                    const int n = n0 + fr, d0 = 16 * dt + 4 * fq; const f32x4 b = *(const GAS f32x4*)(F.in[I_CB2] + d0);
                    f32x4 o = acc[dt] + b; if (n >= N_CMP) o = (f32x4){0.f, 0.f, 0.f, 0.f};
                    v2u w; w.x = pk2(o.x, o.y); w.y = pk2(o.z, o.w); *(GAS v2u*)(KC + (size_t)(g * NCMP_P + n) * 64 + d0) = w;
                    kss += (o.x * o.x + o.y * o.y) + (o.z * o.z + o.w * o.w);
                } else {
                    const int d = 16 * dt + fr, nb = n0 + 4 * fq; const float b = F.in[I_CB2][64 + d];
                    f32x4 o = acc[dt] + b;
                    if (nb + 0 >= N_CMP) o.x = 0.f; if (nb + 1 >= N_CMP) o.y = 0.f; if (nb + 2 >= N_CMP) o.z = 0.f; if (nb + 3 >= N_CMP) o.w = 0.f;
                    v2u w; w.x = pk2(o.x, o.y); w.y = pk2(o.z, o.w); *(GAS v2u*)(VCT + (size_t)(g * 64 + d) * NCMP_P + (n0 & ~31) + 8 * fq + 4 * ((n0 >> 4) & 1)) = w;
                }
            }
            if (j == 0) {
                kss += shx(kss, lane, 16); kss += shx(kss, lane, 32);
#pragma unroll
                for (int o = 1; o < 16; o <<= 1) kss = fmaxf(kss, shx(kss, lane, o));
                if (lane == 0) __hip_atomic_fetch_max(F.ctl + CW_KMAX + 512 + 64 * g, __builtin_bit_cast(unsigned, kss * 1.02f), RLX_AGENT);
            }
        } else {
            const int tt = task - 512, b = tt >> 10, g = (tt >> 8) & 3, t0 = (tt & 255) * 64;
            const int col = (b ? 1280 : 768) + g * 64;
#pragma unroll
            for (int i = 0; i < 8; ++i) { const int row = 8 * i + (lane >> 3), ch = lane & 7;
                const v4u w = *(const GAS v4u*)(KVb + (size_t)(t0 + row) * 1536 + col + ch * 8); *(LAS v4u*)(scr + row * 144 + ch * 16) = w; }
            LDS_WAIT(); asm volatile("" ::: "memory");
#pragma unroll
            for (int i = 0; i < 8; ++i) { const int dd = 8 * i + (lane >> 3), tch = lane & 7;
                unsigned short e[8];
#pragma unroll
                for (int k = 0; k < 8; ++k) e[k] = *(const LAS unsigned short*)(scr + (32 * (tch >> 2) + 16 * (k >> 2) + 4 * (tch & 3) + (k & 3)) * 144 + dd * 2);
                v4u w; w.x = e[0] | ((unsigned)e[1] << 16); w.y = e[2] | ((unsigned)e[3] << 16); w.z = e[4] | ((unsigned)e[5] << 16); w.w = e[6] | ((unsigned)e[7] << 16);
                *(GAS v4u*)(VT + ((size_t)(b * 4 + g) * 64 + dd) * M + t0 + tch * 8) = w; }
            LDS_WAIT(); asm volatile("" ::: "memory");
        }
    }
}

constexpr float LOG2E = 1.4426950408889634f;
__device__ __forceinline__ bf16x8 pack8(const f32x4& a, const f32x4& b) {
    v4u w; w.x = pg8::cvt_pk_bf16(a.x, a.y); w.y = pg8::cvt_pk_bf16(a.z, a.w); w.z = pg8::cvt_pk_bf16(b.x, b.y); w.w = pg8::cvt_pk_bf16(b.z, b.w);
    return __builtin_bit_cast(bf16x8, w);
}
struct AttSt { float l; f32x4 o[4]; };
__device__ __forceinline__ void nsa_attn_phase2(Frame& F) {
    const bf16* Qb = (const bf16*)(F.ws + WS_Q); const bf16* KVb = (const bf16*)(F.ws + WS_KV); const bf16* VT = (const bf16*)(F.ws + WS_VT);
    const bf16* KC = (const bf16*)(F.ws + WS_KCMP); const bf16* VCT = (const bf16*)(F.ws + WS_VCMPT); const float* Gt = (const float*)(F.ws + WS_G);
    bf16* Ob = (bf16*)(F.ws + WS_O);
    const int tid_o = F.tid, w = F.wave;
    LAS unsigned char* STG = F.lds + RING_OFF + 65536;
    const int xcd = blockIdx.x & 7, g = xcd & 3, par = xcd >> 2, idx = blockIdx.x >> 3;
    const int nper = F.G >> 3;
    for (int ui = 0; ui < 4; ++ui) {
        for (int rr = idx; rr < 32; rr += nper) {
        const int m_ = (ui == 0) ? rr : (ui == 1) ? 63 - rr : (ui == 2) ? 64 + rr : 127 - rr;
        const int T = 2 * m_ + par, t0 = 64 * T;
        const int nck = (4 * T + 66) >> 6, nsel = 0, nwin = T + 1 < 9 ? T + 1 : 9, total = 2 * nck + nsel + nwin;
        bf16x8 qf[2][2];
        LAS float* GL = (LAS float*)(F.lds + RING_BYTES + 2048);
        {
            int tz = tid_o; asm volatile("" : "+v"(tz));
            const int lane = tz & 63, fr = lane & 15, fq = lane >> 4, h = fr & 3;
            LAS float* imp = (LAS float*)(F.lds + RING_OFF) + w * 2048;
#pragma unroll
            for (int ct = 0; ct < 2; ++ct) { const int tc = t0 + 8 * w + 4 * ct + (fr >> 2);
                const bf16* qr = Qb + (size_t)tc * 1024 + (g * 4 + h) * 64 + 8 * fq; qf[ct][0] = *(const GAS bf16x8*)qr; qf[ct][1] = *(const GAS bf16x8*)(qr + 32);
                const GAS float* gp = (const GAS float*)Gt + (size_t)tc * 48 + (g * 4 + h) * 3; GL[tz * 6 + ct * 3 + 0] = gp[0]; GL[tz * 6 + ct * 3 + 1] = gp[1]; GL[tz * 6 + ct * 3 + 2] = gp[2]; }
#pragma unroll
            for (int i = 0; i < 8; ++i) *(LAS f32x4*)(imp + 4 * lane + 256 * i) = (f32x4){0.f, 0.f, 0.f, 0.f};
            asm volatile("" :: "v"(qf[0][0]), "v"(qf[0][1]), "v"(qf[1][0]), "v"(qf[1][1]));
        }
        float qn[2], kcm, ksm, kwm;
        {
            int tzq = tid_o; asm volatile("" : "+v"(tzq)); const int lane = tzq & 63;
            const float kcm_ = sqrtf(__builtin_bit_cast(float, __hip_atomic_load(F.ctl + CW_KMAX + 512 + 64 * g, RLX_AGENT))), ksm_ = sqrtf(__builtin_bit_cast(float, __hip_atomic_load(F.ctl + CW_KMAX + 64 * g, RLX_AGENT))),
                        kwm_ = sqrtf(__builtin_bit_cast(float, __hip_atomic_load(F.ctl + CW_KMAX + 256 + 64 * g, RLX_AGENT)));
#pragma unroll
            for (int ct = 0; ct < 2; ++ct) { float ss = 0.f;
#pragma unroll
                for (int ks = 0; ks < 2; ++ks) { const v4u qw = __builtin_bit_cast(v4u, qf[ct][ks]);
                    ss += (bf_lo(qw.x) * bf_lo(qw.x) + bf_hi(qw.x) * bf_hi(qw.x)) + (bf_lo(qw.y) * bf_lo(qw.y) + bf_hi(qw.y) * bf_hi(qw.y)) + (bf_lo(qw.z) * bf_lo(qw.z) + bf_hi(qw.z) * bf_hi(qw.z)) + (bf_lo(qw.w) * bf_lo(qw.w) + bf_hi(qw.w) * bf_hi(qw.w)); }
                ss += shx(ss, lane, 16); ss += shx(ss, lane, 32);
                qn[ct] = sqrtf(ss) * 1.01f; }
            kcm = __builtin_bit_cast(float, __builtin_amdgcn_readfirstlane(__builtin_bit_cast(int, kcm_))); ksm = __builtin_bit_cast(float, __builtin_amdgcn_readfirstlane(__builtin_bit_cast(int, ksm_))); kwm = __builtin_bit_cast(float, __builtin_amdgcn_readfirstlane(__builtin_bit_cast(int, kwm_)));
        }
        float l1[2], inv_l[2], p3prev[2]; int sel[2];
        f32x4 ofin[2][4]; AttSt st[2];
#pragma unroll
        for (int ct = 0; ct < 2; ++ct) { l1[ct] = 0.f; inv_l[ct] = 0.f; p3prev[ct] = 0.f; sel[ct] = -1; st[ct].l = 0.f;
#pragma unroll
            for (int dt = 0; dt < 4; ++dt) { ofin[ct][dt] = (f32x4){0.f, 0.f, 0.f, 0.f}; st[ct].o[dt] = (f32x4){0.f, 0.f, 0.f, 0.f}; } }
#define ATT_DMA(ci_, slot_) do { int c_ = (ci_); c_ = c_ < total ? c_ : total - 1; const int pcl_ = pc_st ^ (r_st0 & 7); const bf16* kp_; const bf16* vp_; \
            if (c_ < nck) { kp_ = KC + (size_t)(g * NCMP_P + 64 * c_ + r_st0) * 64 + pcl_ * 8; vp_ = kp_; } \
            else if (c_ < 2 * nck) { const int cc_ = c_ - nck; kp_ = KC + (size_t)(g * NCMP_P + 64 * cc_ + r_st0) * 64 + pcl_ * 8; vp_ = VCT + (size_t)(g * 64 + r_st0) * NCMP_P + 64 * cc_ + pcl_ * 8; } \
            else if (c_ < 2 * nck + nsel) { const int j_ = c_ - 2 * nck; kp_ = KVb + (size_t)(64 * j_ + r_st0) * 1536 + 512 + g * 64 + pcl_ * 8; vp_ = VT + ((size_t)(0 * 4 + g) * 64 + r_st0) * M + 64 * j_ + pcl_ * 8; } \
            else { const int k0_ = t0 - 64 * (nwin - 1) + 64 * (c_ - 2 * nck - nsel); kp_ = KVb + (size_t)(k0_ + r_st0) * 1536 + 1024 + g * 64 + pcl_ * 8; vp_ = VT + ((size_t)(1 * 4 + g) * 64 + r_st0) * M + k0_ + pcl_ * 8; } \
            __builtin_amdgcn_global_load_lds((const unsigned*)kp_, (LAS unsigned*)(STG + (slot_) * 16384 + w * 1024), 16, 0, 0); \
            __builtin_amdgcn_global_load_lds((const unsigned*)vp_, (LAS unsigned*)(STG + (slot_) * 16384 + 8192 + w * 1024), 16, 0, 0); } while (0)
        asm volatile("s_waitcnt vmcnt(0) lgkmcnt(0)" ::: "memory"); __builtin_amdgcn_s_barrier(); asm volatile("" ::: "memory");
        { int tz = tid_o; asm volatile("" : "+v"(tz)); const int r_st0 = tz >> 3, pc_st = tz & 7;
          ATT_DMA(0, 0); ATT_DMA(1, 1); ATT_DMA(2, 2); }
        int ci = 0;
        for (; ci < nck; ++ci) {
            int tz = tid_o; asm volatile("" : "+v"(tz));
            const int oz = 0, lane = tz & 63, fr = lane & 15, fq = lane >> 4, h = fr & 3, r_st0 = tz >> 3, pc_st = tz & 7;
            unsigned kro[2][2];
#pragma unroll
            for (int kt = 0; kt < 2; ++kt)
#pragma unroll
                for (int ks = 0; ks < 2; ++ks) kro[kt][ks] = (unsigned)((16 * kt + fr) * 128 + (((fq + 4 * ks) ^ (fr & 7)) << 4));
            int tcol[2];
#pragma unroll
            for (int ct = 0; ct < 2; ++ct) tcol[ct] = t0 + 8 * w + 4 * ct + (fr >> 2);
            LAS float* imp = (LAS float*)(F.lds + RING_OFF) + w * 2048;
            asm volatile("s_waitcnt vmcnt(4)" ::: "memory"); __builtin_amdgcn_s_barrier(); asm volatile("" ::: "memory");
            ATT_DMA(ci + 3, (ci + 3) & 3);
            const LAS unsigned char* kb = STG + (ci & 3) * 16384; const LAS unsigned char* vb = kb + 8192;
                const int c = ci;
#pragma nounroll
                for (int k2 = 0; k2 < 2; ++k2) {
                    bf16x8 kf[2][2];
#pragma unroll
                    for (int kt = 0; kt < 2; ++kt)
#pragma unroll
                        for (int ks = 0; ks < 2; ++ks) kf[kt][ks] = *(const LAS bf16x8*)(kb + k2 * 4096 + kro[kt][ks]);
                    {
                        f32x4 e_[2][2];
#pragma unroll
                        for (int ct = 0; ct < 2; ++ct) { const float c0_ = -(qn[ct] * kcm); const f32x4 ci_ = (f32x4){c0_, c0_, c0_, c0_};
#pragma unroll
                            for (int kt = 0; kt < 2; ++kt) e_[ct][kt] = __builtin_amdgcn_mfma_f32_16x16x32_bf16(kf[kt][0], qf[ct][0], ci_, 0, 0, 0); }
#pragma unroll
                        for (int ct = 0; ct < 2; ++ct)
#pragma unroll
                            for (int kt = 0; kt < 2; ++kt) e_[ct][kt] = __builtin_amdgcn_mfma_f32_16x16x32_bf16(kf[kt][1], qf[ct][1], e_[ct][kt], 0, 0, 0);
#pragma unroll
                        for (int ct = 0; ct < 2; ++ct)
#pragma unroll
                            for (int kt = 0; kt < 2; ++kt)
#pragma unroll
                                for (int r = 0; r < 4; ++r) e_[ct][kt][r] = __builtin_amdgcn_exp2f(e_[ct][kt][r]);
                        if (!(16 * (64 * c + 32 * k2 + 31) + 31 <= t0 + 8 * w)) {
#pragma unroll
                            for (int ct = 0; ct < 2; ++ct)
#pragma unroll
                                for (int kt = 0; kt < 2; ++kt)
#pragma unroll
                                    for (int r = 0; r < 4; ++r) { const int n = 64 * c + 32 * k2 + 16 * kt + 4 * fq + r; e_[ct][kt][r] = (16 * n + 31 <= tcol[ct]) ? e_[ct][kt][r] : 0.f; }
                        }
#pragma unroll
                        for (int ct = 0; ct < 2; ++ct) { float ls_ = l1[ct];
#pragma unroll
                            for (int kt = 0; kt < 2; ++kt)
#pragma unroll
                                for (int r = 0; r < 4; ++r) { ls_ += e_[ct][kt][r]; asm("" : "+v"(ls_)); }
                            l1[ct] = ls_; }
                    }
                }
                if (ci == nck - 1) {
#pragma unroll
                    for (int ct = 0; ct < 2; ++ct) { float lsc = l1[ct]; lsc += shx(lsc, lane, 16); lsc += shx(lsc, lane, 32); inv_l[ct] = lsc > 0.f ? -__builtin_amdgcn_logf(lsc) : -3.0e38f; }
                }
        }
        for (; ci < 2 * nck; ++ci) {
            int tz = tid_o; asm volatile("" : "+v"(tz));
            const int oz = 0, lane = tz & 63, fr = lane & 15, fq = lane >> 4, h = fr & 3, r_st0 = tz >> 3, pc_st = tz & 7;
            unsigned kro[2][2];
#pragma unroll
            for (int kt = 0; kt < 2; ++kt)
#pragma unroll
                for (int ks = 0; ks < 2; ++ks) kro[kt][ks] = (unsigned)((16 * kt + fr) * 128 + (((fq + 4 * ks) ^ (fr & 7)) << 4));
            int tcol[2];
#pragma unroll
            for (int ct = 0; ct < 2; ++ct) tcol[ct] = t0 + 8 * w + 4 * ct + (fr >> 2);
            LAS float* imp = (LAS float*)(F.lds + RING_OFF) + w * 2048;
            asm volatile("s_waitcnt vmcnt(4)" ::: "memory"); __builtin_amdgcn_s_barrier(); asm volatile("" ::: "memory");
            ATT_DMA(ci + 3, (ci + 3) & 3);
            const LAS unsigned char* kb = STG + (ci & 3) * 16384; const LAS unsigned char* vb = kb + 8192;
                const int c = ci - nck;
#pragma nounroll
                for (int k2 = 0; k2 < 2; ++k2) {
                    bf16x8 kf[2][2], vf[4];
#pragma unroll
                    for (int kt = 0; kt < 2; ++kt)
#pragma unroll
                        for (int ks = 0; ks < 2; ++ks) kf[kt][ks] = *(const LAS bf16x8*)(kb + k2 * 4096 + kro[kt][ks]);
#pragma unroll
                    for (int dt = 0; dt < 4; ++dt) { const int d = 16 * dt + fr; vf[dt] = *(const LAS bf16x8*)(vb + d * 128 + (((4 * k2 + fq) ^ (d & 7)) << 4)); }
                    {
                        f32x4 p_[2][2];
#pragma unroll
                        for (int ct = 0; ct < 2; ++ct) { const float c0_ = inv_l[ct] - qn[ct] * kcm; const f32x4 ci_ = (f32x4){c0_, c0_, c0_, c0_};
#pragma unroll
                            for (int kt = 0; kt < 2; ++kt) p_[ct][kt] = __builtin_amdgcn_mfma_f32_16x16x32_bf16(kf[kt][0], qf[ct][0], ci_, 0, 0, 0); }
#pragma unroll
                        for (int ct = 0; ct < 2; ++ct)
#pragma unroll
                            for (int kt = 0; kt < 2; ++kt) p_[ct][kt] = __builtin_amdgcn_mfma_f32_16x16x32_bf16(kf[kt][1], qf[ct][1], p_[ct][kt], 0, 0, 0);
#pragma unroll
                        for (int ct = 0; ct < 2; ++ct)
#pragma unroll
                            for (int kt = 0; kt < 2; ++kt)
#pragma unroll
                                for (int r = 0; r < 4; ++r) p_[ct][kt][r] = __builtin_amdgcn_exp2f(p_[ct][kt][r]);
                        if (!(16 * (64 * c + 32 * k2 + 31) + 31 <= t0 + 8 * w)) {
#pragma unroll
                            for (int ct = 0; ct < 2; ++ct)
#pragma unroll
                                for (int kt = 0; kt < 2; ++kt)
#pragma unroll
                                    for (int r = 0; r < 4; ++r) { const int n = 16 * (4 * c + 2 * k2 + kt) + 4 * fq + r; p_[ct][kt][r] = (16 * n + 31 <= tcol[ct]) ? p_[ct][kt][r] : 0.f; }
                        }
#pragma unroll
                        for (int ct = 0; ct < 2; ++ct) {
#pragma unroll
                            for (int kt = 0; kt < 2; ++kt) { const int nt = 4 * c + 2 * k2 + kt;
                                const float quad = ((p_[ct][kt][0] + p_[ct][kt][1]) + p_[ct][kt][2]) + p_[ct][kt][3];
                                const float rot = shl_from(p_[ct][kt][3], (lane + 48) & 63);
                                float v = quad + (fq == 0 ? p3prev[ct] : rot);
                                p3prev[ct] = rot;
                                v += dpp_xor1(v); v += dpp_xor2(v);
                                if (h == 0) imp[(ct * 4 + (fr >> 2)) * 256 + 4 * nt + fq] = v; }
                            const bf16x8 pb = pack8(p_[ct][0], p_[ct][1]);
#pragma unroll
                            for (int dt = 0; dt < 4; ++dt) st[ct].o[dt] = __builtin_amdgcn_mfma_f32_16x16x32_bf16(vf[dt], pb, st[ct].o[dt], 0, 0, 0);
                        }
                    }
                }
                if (ci == 2 * nck - 1) {
                                    asm volatile("s_waitcnt lgkmcnt(0)" ::: "memory");
                    {
                        const int tk = lane >> 4, r16 = lane & 15, jt = T;
                        float vals[2][16]; int sl[2];
#pragma unroll
                        for (int ct = 0; ct < 2; ++ct) {
#pragma unroll
                            for (int i = 0; i < 16; ++i) { const int j = r16 + 16 * i; const bool forced = (j == 0) || (j == jt) || (j == jt - 1);
                                vals[ct][i] = (j <= jt && !forced) ? imp[(ct * 4 + tk) * 256 + j] : -3.0e38f; }
                            sl[ct] = (r16 == 0) ? 0 : (r16 == 1 ? (jt >= 1 ? jt : -1) : (r16 == 2 ? (jt >= 2 ? jt - 1 : -1) : -1)); }
#define TOPK_ROUNDS(NV) do { _Pragma("nounroll") for (int rd = 3; rd < 16; ++rd) { \
                            _Pragma("unroll") for (int ct = 0; ct < 2; ++ct) { \
                                float bv = vals[ct][0]; int bi = 0; \
                                _Pragma("unroll") for (int i = 1; i < NV; ++i) if (vals[ct][i] > bv) { bv = vals[ct][i]; bi = i; } \
                                asm("" : "+v"(bi));     \
                                unsigned khi = bv >= 0.f ? __builtin_bit_cast(unsigned, bv) + 1u : 0u, klo = ~(unsigned)(r16 + 16 * bi); \
                                { unsigned ohi, olo; \
                                  ohi = (unsigned)dpp_xor1i((int)khi); olo = (unsigned)dpp_xor1i((int)klo); if ((((unsigned long long)ohi << 32) | olo) > (((unsigned long long)khi << 32) | klo)) { khi = ohi; klo = olo; } \
                                  ohi = (unsigned)dpp_xor2i((int)khi); olo = (unsigned)dpp_xor2i((int)klo); if ((((unsigned long long)ohi << 32) | olo) > (((unsigned long long)khi << 32) | klo)) { khi = ohi; klo = olo; } \
                                  ohi = (unsigned)dpp_hmiri((int)khi); olo = (unsigned)dpp_hmiri((int)klo); if ((((unsigned long long)ohi << 32) | olo) > (((unsigned long long)khi << 32) | klo)) { khi = ohi; klo = olo; } \
                                  ohi = (unsigned)dpp_miri((int)khi);  olo = (unsigned)dpp_miri((int)klo);  if ((((unsigned long long)ohi << 32) | olo) > (((unsigned long long)khi << 32) | klo)) { khi = ohi; klo = olo; } } \
                                const int bj = (int)~klo; \
                                if (r16 == rd) sl[ct] = khi != 0u ? bj : -1; \
                                _Pragma("unroll") for (int i = 0; i < NV; ++i) if ((bj & 15) == r16 && (bj >> 4) == i) vals[ct][i] = -3.0e38f; \
                            } } } while (0)
                        if (jt < 32) TOPK_ROUNDS(2); else if (jt < 64) TOPK_ROUNDS(4); else if (jt < 128) TOPK_ROUNDS(8); else if (jt < 192) TOPK_ROUNDS(12); else TOPK_ROUNDS(16);
#undef TOPK_ROUNDS
                        sel[0] = sl[0]; sel[1] = sl[1];
                    }
#pragma unroll
                    for (int ct = 0; ct < 2; ++ct) { const float gc = GL[tz * 6 + ct * 3 + 0];
#pragma unroll
                        for (int dt = 0; dt < 4; ++dt) { ofin[ct][dt] = st[ct].o[dt] * gc; st[ct].o[dt] = (f32x4){0.f, 0.f, 0.f, 0.f}; }
                        st[ct].l = 0.f;
                    }
                }
        }
        for (; ci < total; ++ci) {
            int tz = tid_o; asm volatile("" : "+v"(tz));
            const int oz = 0, lane = tz & 63, fr = lane & 15, fq = lane >> 4, h = fr & 3, r_st0 = tz >> 3, pc_st = tz & 7;
            unsigned kro[2][2];
#pragma unroll
            for (int kt = 0; kt < 2; ++kt)
#pragma unroll
                for (int ks = 0; ks < 2; ++ks) kro[kt][ks] = (unsigned)((16 * kt + fr) * 128 + (((fq + 4 * ks) ^ (fr & 7)) << 4));
            int tcol[2];
#pragma unroll
            for (int ct = 0; ct < 2; ++ct) tcol[ct] = t0 + 8 * w + 4 * ct + (fr >> 2);
            LAS float* imp = (LAS float*)(F.lds + RING_OFF) + w * 2048;
            asm volatile("s_waitcnt vmcnt(4)" ::: "memory"); __builtin_amdgcn_s_barrier(); asm volatile("" ::: "memory");
            ATT_DMA(ci + 3, (ci + 3) & 3);
            const LAS unsigned char* kb = STG + (ci & 3) * 16384; const LAS unsigned char* vb = kb + 8192;
                const int key0 = t0 - 64 * (nwin - 1) + 64 * (ci - 2 * nck);
#pragma nounroll
                for (int k2 = 0; k2 < 2; ++k2) {
                    bf16x8 kf[2][2], vf[4];
#pragma unroll
                    for (int kt = 0; kt < 2; ++kt)
#pragma unroll
                        for (int ks = 0; ks < 2; ++ks) kf[kt][ks] = *(const LAS bf16x8*)(kb + k2 * 4096 + kro[kt][ks]);
#pragma unroll
                    for (int dt = 0; dt < 4; ++dt) { const int d = 16 * dt + fr; vf[dt] = *(const LAS bf16x8*)(vb + d * 128 + (((4 * k2 + fq) ^ (d & 7)) << 4)); }
                    const int kk0 = key0 + 32 * k2;
                    {
                        f32x4 pp[2][2];
#pragma unroll
                        for (int ct = 0; ct < 2; ++ct) { const float c0_ = -(qn[ct] * kwm); const f32x4 ci_ = (f32x4){c0_, c0_, c0_, c0_};
#pragma unroll
                            for (int kt = 0; kt < 2; ++kt) pp[ct][kt] = __builtin_amdgcn_mfma_f32_16x16x32_bf16(kf[kt][0], qf[ct][0], ci_, 0, 0, 0); }
#pragma unroll
                        for (int ct = 0; ct < 2; ++ct)
#pragma unroll
                            for (int kt = 0; kt < 2; ++kt) pp[ct][kt] = __builtin_amdgcn_mfma_f32_16x16x32_bf16(kf[kt][1], qf[ct][1], pp[ct][kt], 0, 0, 0);
#pragma unroll
                        for (int ct = 0; ct < 2; ++ct)
#pragma unroll
                            for (int kt = 0; kt < 2; ++kt)
#pragma unroll
                                for (int r = 0; r < 4; ++r) pp[ct][kt][r] = __builtin_amdgcn_exp2f(pp[ct][kt][r]);
                        if (!((kk0 + 31 <= t0 + 8 * w) && (kk0 > t0 + 8 * w + 7 - 512))) {
#pragma unroll
                            for (int ct = 0; ct < 2; ++ct)
#pragma unroll
                                for (int kt = 0; kt < 2; ++kt)
#pragma unroll
                                    for (int r = 0; r < 4; ++r) { const int key = kk0 + 16 * kt + 4 * fq + r; pp[ct][kt][r] = (key <= tcol[ct] && key > tcol[ct] - 512) ? pp[ct][kt][r] : 0.f; }
                        }
#pragma unroll
                        for (int ct = 0; ct < 2; ++ct) {
                            { float ls_ = st[ct].l;
#pragma unroll
                              for (int kt = 0; kt < 2; ++kt)
#pragma unroll
                                  for (int r = 0; r < 4; ++r) { ls_ += pp[ct][kt][r]; asm("" : "+v"(ls_)); }
                              st[ct].l = ls_; }
                            const bf16x8 pb = pack8(pp[ct][0], pp[ct][1]);
#pragma unroll
                            for (int dt = 0; dt < 4; ++dt) st[ct].o[dt] = __builtin_amdgcn_mfma_f32_16x16x32_bf16(vf[dt], pb, st[ct].o[dt], 0, 0, 0);
                        }
                    }
                }
                if (ci == total - 1) {
#pragma unroll
                    for (int ct = 0; ct < 2; ++ct) {
                        float ls = st[ct].l; ls += shx(ls, lane, 16); ls += shx(ls, lane, 32);
                        const float gg = GL[tz * 6 + ct * 3 + 2] * __builtin_amdgcn_rcpf(ls);
#pragma unroll
                        for (int dt = 0; dt < 4; ++dt) { ofin[ct][dt] = ofin[ct][dt] + st[ct].o[dt] * gg; st[ct].o[dt] = (f32x4){0.f, 0.f, 0.f, 0.f}; }
                        st[ct].l = 0.f;
                    }
                }
        }
        {
            int tz = tid_o; asm volatile("" : "+v"(tz));
            const int lane = tz & 63, fr = lane & 15, fq = lane >> 4, h = fr & 3, r_st0 = tz >> 3, pc_st = tz & 7;
#pragma unroll
            for (int ct = 0; ct < 2; ++ct) { st[ct].l = 0.f;
#pragma unroll
                for (int dt = 0; dt < 4; ++dt) st[ct].o[dt] = (f32x4){0.f, 0.f, 0.f, 0.f}; }
            const int nwnd = (T + 4) >> 2;
            LAS unsigned char* HB = F.lds + RING_OFF;
#define SLC_DMA(k_, half_) do { const int pcl_ = pc_st ^ (r_st0 & 7); _Pragma("unroll") for (int b_ = 0; b_ < 4; ++b_) { int j_ = 4 * (k_) + b_; j_ = j_ < T ? j_ : T; \
                const bf16* kp_ = KVb + (size_t)(64 * j_ + r_st0) * 1536 + 512 + g * 64 + pcl_ * 8; const bf16* vp_ = VT + ((size_t)g * 64 + r_st0) * M + 64 * j_ + pcl_ * 8; \
                __builtin_amdgcn_global_load_lds((const unsigned*)kp_, (LAS unsigned*)(HB + (half_) * 65536 + b_ * 16384 + w * 1024), 16, 0, 0); \
                __builtin_amdgcn_global_load_lds((const unsigned*)vp_, (LAS unsigned*)(HB + (half_) * 65536 + b_ * 16384 + 8192 + w * 1024), 16, 0, 0); } } while (0)
#ifndef MK_PROBE_A
#define MK_PROBE_A 0
#endif
            for (int ppass_ = 0; ppass_ < (MK_PROBE_A == 1 ? 2 : 1); ++ppass_) {
            asm volatile("s_waitcnt vmcnt(0) lgkmcnt(0)" ::: "memory"); __builtin_amdgcn_s_barrier(); asm volatile("" ::: "memory");
            { int tz3 = tid_o; asm volatile("" : "+v"(tz3)); const int r_st0 = tz3 >> 3, pc_st = tz3 & 7; SLC_DMA(0, 0); }
            for (int k = 0; k < nwnd; ++k) {
                int tz2 = tid_o; asm volatile("" : "+v"(tz2));
                const int lane = tz2 & 63, fr = lane & 15, fq = lane >> 4, r_st0 = tz2 >> 3, pc_st = tz2 & 7;
                asm volatile("s_waitcnt vmcnt(0)" ::: "memory"); __builtin_amdgcn_s_barrier(); asm volatile("" ::: "memory");
                if (k + 1 < nwnd) SLC_DMA(k + 1, (k + 1) & 1);
#pragma nounroll
                for (int b = 0; b < 4; ++b) {
                    const int j = 4 * k + b;
                    bool act[2], cs[2];
#pragma unroll
                    for (int ct = 0; ct < 2; ++ct) { const unsigned long long mk = __ballot(sel[ct] == j); act[ct] = mk != 0ull; cs[ct] = ((mk >> (16 * (fr >> 2))) & 0xFFFFull) != 0ull; }
                    if (!(act[0] || act[1])) continue;
                    const LAS unsigned char* kb = HB + (k & 1) * 65536 + b * 16384; const LAS unsigned char* vb = kb + 8192;
                    bf16x8 kf[4][2], vf[4][2];
#pragma unroll
                    for (int kt = 0; kt < 4; ++kt)
#pragma unroll
                        for (int ks = 0; ks < 2; ++ks) kf[kt][ks] = *(const LAS bf16x8*)(kb + (16 * kt + fr) * 128 + (((fq + 4 * ks) ^ (fr & 7)) << 4));
#pragma unroll
                    for (int dt = 0; dt < 4; ++dt)
#pragma unroll
                        for (int k2 = 0; k2 < 2; ++k2) { const int d = 16 * dt + fr; vf[dt][k2] = *(const LAS bf16x8*)(vb + d * 128 + (((4 * k2 + fq) ^ (d & 7)) << 4)); }
#pragma unroll
                    for (int ct = 0; ct < 2; ++ct) if (act[ct]) {
                        const int tc = t0 + 8 * w + 4 * ct + (fr >> 2);
                        const float mre = cs[ct] ? qn[ct] * ksm : 3.0e38f;
                        {
                            f32x4 pp[4]; const f32x4 ci_ = (f32x4){-mre, -mre, -mre, -mre};
#pragma unroll
                            for (int kt = 0; kt < 4; ++kt) pp[kt] = __builtin_amdgcn_mfma_f32_16x16x32_bf16(kf[kt][0], qf[ct][0], ci_, 0, 0, 0);
#pragma unroll
                            for (int kt = 0; kt < 4; ++kt) pp[kt] = __builtin_amdgcn_mfma_f32_16x16x32_bf16(kf[kt][1], qf[ct][1], pp[kt], 0, 0, 0);
#pragma unroll
                            for (int kt = 0; kt < 4; ++kt)
#pragma unroll
                                for (int r = 0; r < 4; ++r) pp[kt][r] = __builtin_amdgcn_exp2f(pp[kt][r]);
                            if (j == T) {
#pragma unroll
                                for (int kt = 0; kt < 4; ++kt)
#pragma unroll
                                    for (int r = 0; r < 4; ++r) { const int key = 64 * j + 16 * kt + 4 * fq + r; pp[kt][r] = key <= tc ? pp[kt][r] : 0.f; }
                            }
                            const bf16x8 pb0 = pack8(pp[0], pp[1]), pb1 = pack8(pp[2], pp[3]);
                            { float ls_ = st[ct].l;
#pragma unroll
                              for (int kt = 0; kt < 4; ++kt)
#pragma unroll
                                  for (int r = 0; r < 4; ++r) { ls_ += pp[kt][r]; asm("" : "+v"(ls_)); }
                              st[ct].l = ls_; }
#pragma unroll
                            for (int dt = 0; dt < 4; ++dt) st[ct].o[dt] = __builtin_amdgcn_mfma_f32_16x16x32_bf16(vf[dt][0], pb0, st[ct].o[dt], 0, 0, 0);
#pragma unroll
                            for (int dt = 0; dt < 4; ++dt) st[ct].o[dt] = __builtin_amdgcn_mfma_f32_16x16x32_bf16(vf[dt][1], pb1, st[ct].o[dt], 0, 0, 0);
                        }
                    }
                }
            }
            }
#undef SLC_DMA
            asm volatile("s_waitcnt lgkmcnt(0)" ::: "memory"); __builtin_amdgcn_s_barrier(); asm volatile("" ::: "memory");
#pragma unroll
            for (int ct = 0; ct < 2; ++ct) {
                float ls = st[ct].l; ls += shx(ls, lane, 16); ls += shx(ls, lane, 32);
                const float gg = GL[tz * 6 + ct * 3 + 1] * __builtin_amdgcn_rcpf(ls);
#pragma unroll
                for (int dt = 0; dt < 4; ++dt) { const f32x4 o = ofin[ct][dt] + st[ct].o[dt] * gg; v2u wv; wv.x = pk2(o.x, o.y); wv.y = pk2(o.z, o.w);
                    *(LAS v2u*)(F.lds + RING_OFF + w * 8192 + ((4 * ct + (fr >> 2)) * 4 + h) * 144 + dt * 32 + fq * 8) = wv; }
            }
#pragma unroll
            for (int i = 0; i < 4; ++i) { const int P = i * 64 + lane, tl = P >> 5, q = P & 31;
                const v4u wv = *(const LAS v4u*)(F.lds + RING_OFF + w * 8192 + (tl * 4 + (q >> 3)) * 144 + (q & 7) * 16);
                *(GAS v4u*)(Ob + (size_t)(t0 + 8 * w + tl) * 1024 + g * 256 + q * 8) = wv; }
        }
#undef ATT_DMA
        }
    }
}
#ifndef MK_PER_PHASE
#define MK_PER_PHASE 0
#endif
#ifndef MK_STOP_LAYERS
#define MK_STOP_LAYERS 4
#endif
#ifndef MK_MASK
#define MK_MASK 0xFFFFFFFFu
#endif
#define EN(b) ((MK_MASK >> (b)) & 1u)
#ifndef MK_REPEAT
#define MK_REPEAT 0u
#endif
#define REP(b) ((MK_REPEAT >> (b)) & 1u)
constexpr int SLOTS = 11, NPH = 2 + DEPTH * SLOTS;
struct Args { const float* in[N_IN]; float* out; unsigned char* ws; int ph_lo, ph_hi; };
__host__ __device__ inline bool phase_exists(int pid) {
    if (pid < 2) return true;
    const int layer = (pid - 2) / SLOTS, slot = (pid - 2) % SLOTS;
    if (layer >= MK_STOP_LAYERS) return false;
    if (slot <= 2) return layer == 2;
    if (slot == 3) return layer != 2;
    if (slot == 7) return false;
    return true;
}
__global__ void __launch_bounds__(NWAVES * 64, 2) fwd_kernel(Args args) {
    extern __shared__ __attribute__((aligned(16))) unsigned char lds[];
    Frame F;
    F.lds = (LAS unsigned char*)lds;
    F.MISC = (volatile LAS unsigned*)(F.lds + MISC_OFF);
    F.tid = threadIdx.x; F.lane = F.tid & 63; F.wave = __builtin_amdgcn_readfirstlane(F.tid >> 6);
    F.G = gridDim.x; F.gw = blockIdx.x * NWAVES + F.wave; F.NGW = F.G * NWAVES;
    F.ws = args.ws; F.ctl = (gu32*)(args.ws + WS_CTL); F.X = args.out;
#pragma unroll
    for (int i = 0; i < N_IN; ++i) F.in[i] = args.in[i];
    for (int u = F.tid; u < (LDS_BYTES - LDSCTL_OFF) / 4; u += NWAVES * 64) ((LAS unsigned*)(F.lds + LDSCTL_OFF))[u] = 0u;
    __syncthreads();
    XcdBarrier bar; bar.bar = (unsigned*)(F.ctl + CW_BAR); bar.x = 0; bar.st = nullptr;
    if (!MK_PER_PHASE) bar = xcd_barrier_post((unsigned*)(F.ctl + CW_BAR), F.MISC + 8);
    const int lo = args.ph_lo, hi = args.ph_hi;
#define IN(k) (lo <= (k) && (k) < hi)
#define PHASE_BEGIN() Frame P = F; { unsigned on_ = ~0u; asm volatile("" : "+s"(on_)); int t_ = F.wave * 64 + (int)__builtin_amdgcn_mbcnt_hi(on_, __builtin_amdgcn_mbcnt_lo(on_, 0u));   asm volatile("" : "+v"(t_)); unsigned char* w_ = args.ws; asm volatile("" : "+s"(w_)); P.tid = t_; P.lane = t_ & 63; P.wave = __builtin_amdgcn_readfirstlane(t_ >> 6); P.gw = blockIdx.x * NWAVES + P.wave; P.ws = w_; P.ctl = (gu32*)(w_ + WS_CTL); } unsigned char* ws = P.ws; LAS unsigned char* ring = P.lds + RING_OFF; const int ptid = P.tid; (void)ws; (void)ring; (void)ptid
#ifndef MK_DOUBLE_BAR
#define MK_DOUBLE_BAR 0
#endif
#define SEAM(k) do { if (!MK_PER_PHASE && (k) + 1 < hi) { xcd_barrier(bar); if (MK_DOUBLE_BAR) xcd_barrier(bar); } } while (0)

    if (EN(0) && IN(0)) for (int rep_ = 0; rep_ < 1 + (int)REP(0); ++rep_) { PHASE_BEGIN(); p0_prologue(P); SEAM(0); }
    if (EN(1) && IN(1)) for (int rep_ = 0; rep_ < 1 + (int)REP(1); ++rep_) { PHASE_BEGIN(); thin_phase<1, 0, 1, 0, 0>(P, 0, 0, 0, 0, 0, 0); SEAM(1); }

    for (int layer = 0; layer < MK_STOP_LAYERS; ++layer) {
        const int base = 2 + layer * SLOTS;
        const int j2 = layer >> 1;
        if (layer < 2) {
            if (EN(2) && IN(base + 3)) for (int rep_ = 0; rep_ < 1 + (int)REP(2); ++rep_) { PHASE_BEGIN();
                pg8::Gemm g{(const char*)(ws + WS_H), (const char*)(ws + W_AIN) + (size_t)layer * 4096 * 1024 * 2, 1024, 1024u, 1024u, 128u};
                pg8::StaticOrder S; S.init(M, 4096, F.G, (int)blockIdx.x);
                pg8::EpiBf16<1> E{(bf16*)(ws + WS_U), 2048, nullptr, 2048, (size_t)(WS_V - WS_U) / 2, 1.0f, -1, 0};
                pg8::gemm_phase<pg8::EpiBf16<1>, pg8::StaticOrder>(ptid, ring, g, S, E);
                SEAM(base + 3);
            }
            if (EN(3) && IN(base + 4)) for (int rep_ = 0; rep_ < 1 + (int)REP(3); ++rep_) { PHASE_BEGIN(); spatial_phase(P, layer); SEAM(base + 4); }
            if (EN(4) && IN(base + 5)) for (int rep_ = 0; rep_ < 1 + (int)REP(4); ++rep_) { PHASE_BEGIN();
                pg8::Gemm g{(const char*)(ws + WS_UM), (const char*)(ws + W_AOUT) + (size_t)layer * 1024 * KP2 * 2, 2048, (unsigned)KP2, (unsigned)KP2, 128u};
                pg8::StaticOrder S; S.init(M, 1024, F.G, (int)blockIdx.x);
                pg8::EpiBf16<0> E{(bf16*)(ws + WS_Y), 1024, nullptr, 0, 0, 1.0f, -1, 0};
                pg8::gemm_phase<pg8::EpiBf16<0>, pg8::StaticOrder>(ptid, ring, g, S, E);
                SEAM(base + 5);
            }
        } else {
            const int li = layer - 2;
            if (layer == 2) {
                if (EN(5) && IN(base + 0)) for (int rep_ = 0; rep_ < 1 + (int)REP(5); ++rep_) { PHASE_BEGIN();
                    pg8::Gemm g{(const char*)(ws + WS_HKV), (const char*)(ws + W_KV), 1024, 1024u, 1024u, 128u};
                    pg8::StaticOrder S; S.init(M, 1536, F.G, (int)blockIdx.x);
                    pg8::EpiBf16<0> E{(bf16*)(ws + WS_KV), 1536, nullptr, 0, 0, 1.0f, -1, 0};
                    pg8::gemm_phase<pg8::EpiBf16<0>, pg8::StaticOrder>(ptid, ring, g, S, E);
                    pg8::Gemm g2{(const char*)(ws + WS_H), (const char*)(ws + W_BIN), 1024, 1024u, 1024u, 128u};
                    pg8::StaticOrder S2; S2.init(M, NQG, F.G, (int)(F.G - 1 - blockIdx.x));
                    pg8::EpiQG E2{(bf16*)(ws + WS_Q), (float*)(ws + WS_G), 0.125f * 1.4426950408889634f};
                    pg8::gemm_phase<pg8::EpiQG, pg8::StaticOrder>(ptid, ring, g2, S2, E2);
                    SEAM(base + 0);
                }
                if (EN(6) && IN(base + 1)) for (int rep_ = 0; rep_ < 1 + (int)REP(6); ++rep_) { PHASE_BEGIN();
                    pg8::Gemm g{(const char*)(ws + WS_KV), (const char*)(ws + W_C1), 2048, 16u * 1536u, 2048u, 1536u * 2u};
                    CmpOrder S{F.G, (int)blockIdx.x};
                    pg8::EpiBf16<1> E{(bf16*)(ws + WS_HID), 256, (const float*)(ws + WS_CB1), 0, 0, 1.0f, 4, 256};
                    pg8::gemm_phase<pg8::EpiBf16<1>, CmpOrder>(ptid, ring, g, S, E);
                    if (blockIdx.x >= 32) cmp2_vt_phase<1>(P, (int)(blockIdx.x - 32) * NWAVES + P.wave, (int)(F.G - 32) * NWAVES);
                    SEAM(base + 1);
                }
                if (EN(7) && IN(base + 2)) for (int rep_ = 0; rep_ < 1 + (int)REP(7); ++rep_) { PHASE_BEGIN(); cmp2_vt_phase<0>(P, P.gw, P.NGW); SEAM(base + 2); }
            }
            if (layer == 3 && EN(8) && IN(base + 3)) for (int rep_ = 0; rep_ < 1 + (int)REP(8); ++rep_) { PHASE_BEGIN();
                pg8::Gemm g{(const char*)(ws + WS_H), (const char*)(ws + W_BIN) + (size_t)li * NQG * 1024 * 2, 1024, 1024u, 1024u, 128u};
                pg8::StaticOrder S; S.init(M, NQG, F.G, (int)blockIdx.x);
                pg8::EpiQG E{(bf16*)(ws + WS_Q), (float*)(ws + WS_G), 0.125f * 1.4426950408889634f};
                pg8::gemm_phase<pg8::EpiQG, pg8::StaticOrder>(ptid, ring, g, S, E);
                SEAM(base + 3);
            }
            if (EN(9) && IN(base + 4)) for (int rep_ = 0; rep_ < 1 + (int)REP(9); ++rep_) { PHASE_BEGIN(); nsa_attn_phase2(P); SEAM(base + 4); }
            if (EN(10) && IN(base + 5)) for (int rep_ = 0; rep_ < 1 + (int)REP(10); ++rep_) { PHASE_BEGIN();
                pg8::Gemm g{(const char*)(ws + WS_O), (const char*)(ws + W_BOUT) + (size_t)li * 1024 * 1024 * 2, 1024, 1024u, 1024u, 128u};
                pg8::StaticOrder S; S.init(M, 1024, F.G, (int)blockIdx.x);
                pg8::EpiBf16<0> E{(bf16*)(ws + WS_Y), 1024, nullptr, 0, 0, 1.0f, -1, 0};
                pg8::gemm_phase<pg8::EpiBf16<0>, pg8::StaticOrder>(ptid, ring, g, S, E);
                SEAM(base + 5);
            }
        }
        if (EN(11) && IN(base + 6)) for (int rep_ = 0; rep_ < 1 + (int)REP(11); ++rep_) { PHASE_BEGIN();
            if (layer & 1) thin_phase<0, 1, 1, 0, 1>(P, layer, 0, layer, 1, 0, j2);
            else           thin_phase<0, 1, 1, 0, 0, FFN_F8>(P, layer, 0, layer, 1, 0, 0);
            SEAM(base + 6);
        }
        if ((layer & 1) == 0) {
            if (EN(12) && IN(base + 8)) for (int rep_ = 0; rep_ < 1 + (int)REP(12); ++rep_) { PHASE_BEGIN();
                pg8::StaticOrder S; S.init(M, 5632, F.G, (int)blockIdx.x);
#if FFN_F8
                pg8::Gemm g{(const char*)(ws + WS_H), (const char*)(ws + W_FGU) + (size_t)j2 * 5632 * 1024, 512, 512u, 512u, 128u};
                pg8::EpiSwigluS E{(bf16*)(ws + WS_ACT), DFF, 1.0f / MOE_SW_GU};
                pg8::gemm_phase<pg8::EpiSwigluS, pg8::StaticOrder, true, true>(ptid, ring, g, S, E);
#else
                pg8::Gemm g{(const char*)(ws + WS_H), (const char*)(ws + W_FGU) + (size_t)j2 * 5632 * 1024 * 2, 1024, 1024u, 1024u, 128u};
                pg8::EpiSwiglu E{(bf16*)(ws + WS_ACT), DFF};
                pg8::gemm_phase<pg8::EpiSwiglu, pg8::StaticOrder>(ptid, ring, g, S, E);
#endif
                SEAM(base + 8);
            }
            if (EN(13) && IN(base + 9)) for (int rep_ = 0; rep_ < 1 + (int)REP(13); ++rep_) { PHASE_BEGIN();
                pg8::Gemm g{(const char*)(ws + WS_ACT), (const char*)(ws + W_FD) + (size_t)j2 * 1024 * DFF * 2, DFF, (unsigned)DFF, (unsigned)DFF, 128u};
                pg8::StaticOrder S; S.init(M, 1024, F.G, (int)blockIdx.x);
                pg8::EpiBf16<0> E{(bf16*)(ws + WS_Y), 1024, nullptr, 0, 0, 1.0f, -1, 0};
                pg8::gemm_phase<pg8::EpiBf16<0>, pg8::StaticOrder>(ptid, ring, g, S, E);
                SEAM(base + 9);
            }
        } else {
            if (EN(15) && IN(base + 8)) for (int rep_ = 0; rep_ < 1 + (int)REP(15); ++rep_) { PHASE_BEGIN();
                int pstart[8]; MoeOrderT<1> S; moe_offsets(P, j2, pstart, S.pend_t);
                S.nM = S.pend_t[7]; S.nN = 28; S.G = F.G; S.c = (int)blockIdx.x; S.estride = (size_t)7168 * 1024; S.ksplit = 0; S.khalf_bytes = 0; S.afixed = 1;
                const int early = M3_SPLIT ? 0 : moe_early_tiles(S.nM, F.G); S.early = early;
                unsigned* ecnt = (unsigned*)(P.ctl + CW_EARLY + 64 * j2);
                pg8::Gemm g{(const char*)(ws + WS_XBUF), (const char*)(ws + W_MGU) + (size_t)j2 * 8 * 7168 * 1024, 512, 512u, 512u, 128u};
                pg8::EpiSwigluF8 E{(unsigned char*)(ws + WS_ACTM), DEXP, 1.0f / MOE_SW_GU, MOE_SA, ecnt, early >> 2};
                pg8::gemm_phase<pg8::EpiSwigluF8, MoeOrderT<1>, true, true>(ptid, ring, g, S, E);
            }
            if (EN(15) && IN(base + 8)) { PHASE_BEGIN();
                int pstart[8]; MoeOrderT<1> S; moe_offsets(P, j2, pstart, S.pend_t);
                S.nM = S.pend_t[7]; S.G = F.G; S.c = (int)blockIdx.x;
                const int early = M3_SPLIT ? 0 : moe_early_tiles(S.nM, F.G);
                unsigned* ecnt = (unsigned*)(P.ctl + CW_EARLY + 64 * j2);
                if (early > 0 && (int)blockIdx.x >= F.G - early) {
                    const int pm_e = ((int)blockIdx.x - (F.G - early)) >> 2;
                    if (ptid == 0) { unsigned sp_ = 0u; while (__hip_atomic_load(ecnt + pm_e, __ATOMIC_RELAXED, __HIP_MEMORY_SCOPE_AGENT) < 28u * 8u * (1u + REP(15) * 0u) && ++sp_ < 40000000u) __builtin_amdgcn_s_sleep(2);
                        __builtin_amdgcn_fence(__ATOMIC_ACQUIRE, "agent"); }
                    __syncthreads();
                    MoeOrderT<3> S3; S3.nM = S.nM; S3.G = S.G; S3.c = S.c; S3.early = early; S3.ksplit = 0; S3.khalf_bytes = 0;
#pragma unroll
                    for (int e_ = 0; e_ < 8; ++e_) S3.pend_t[e_] = S.pend_t[e_];
                    S3.nN = 4; S3.estride = (size_t)1024 * DEXP; S3.afixed = 0;
                    pg8::Gemm g3{(const char*)(ws + WS_ACTM), (const char*)(ws + W_MD) + (size_t)j2 * 8 * 1024 * DEXP, DEXP / 2, (unsigned)DEXP / 2u, (unsigned)DEXP / 2u, 128u};
                    pg8::EpiBf16<0> E3{(bf16*)(ws + WS_YBUF), 1024, nullptr, 0, 0, 1.0f / (MOE_SW_D * MOE_SA), -1, 0};
                    int ptid3 = ptid; asm volatile("" : "+v"(ptid3));
                    pg8::gemm_phase<pg8::EpiBf16<0>, MoeOrderT<3>, true, true>(ptid3, ring, g3, S3, E3);
                }
                SEAM(base + 8);
            }
            if (EN(16) && IN(base + 9)) for (int rep_ = 0; rep_ < 1 + (int)REP(16); ++rep_) { PHASE_BEGIN();
                int pstart[8]; MoeOrderT<2> S; moe_offsets(P, j2, pstart, S.pend_t);
                S.nM = S.pend_t[7]; S.nN = M3_SPLIT ? 8 : 4; S.G = F.G; S.c = (int)blockIdx.x; S.estride = (size_t)1024 * DEXP; S.ksplit = M3_SPLIT; S.khalf_bytes = (size_t)(DEXP / 2); S.afixed = 0;
                S.early = M3_SPLIT ? 0 : moe_early_tiles(S.nM, F.G);
                pg8::Gemm g{(const char*)(ws + WS_ACTM), (const char*)(ws + W_MD) + (size_t)j2 * 8 * 1024 * DEXP, M3_SPLIT ? DEXP / 4 : DEXP / 2, (unsigned)DEXP / 2u, (unsigned)DEXP / 2u, 128u};
                pg8::EpiBf16<0> E{(bf16*)(ws + WS_XBUF2), 1024, nullptr, M3_SPLIT ? 1024 : 0, (size_t)(WS_YBUF - WS_XBUF2) / 2, 1.0f / (MOE_SW_D * MOE_SA), -1, 0};
                pg8::gemm_phase<pg8::EpiBf16<0>, MoeOrderT<2>, true, true>(ptid, ring, g, S, E);
                SEAM(base + 9);
            }
        }
        if (EN(17) && IN(base + 10)) for (int rep_ = 0; rep_ < 1 + (int)REP(17); ++rep_) { PHASE_BEGIN();
            if (layer == 0)      thin_phase<0, 1, 1, 0, 0>(P, 0, 1, 1, 0, 0, 0);
            else if (layer == 1) thin_phase<0, 2, 1, 1, 0>(P, 1, 1, 2, 0, 0, 0);
            else if (layer == 2) thin_phase<0, 1, 1, 0, 0>(P, 2, 1, 3, 0, 0, 0);
            else                 thin_phase<0, 2, 0, 0, 0>(P, 3, 1, 0, 0, 1, 0);
            SEAM(base + 10);
        }
    }
#undef IN
#undef SEAM
}

extern "C" void kernel_launch(void* const* d_in, const int* in_sizes, int n_in, void* d_out, int out_size, void* d_ws, size_t ws_size, hipStream_t stream) {
    static int grid = 0;
    if (grid == 0) {
        if (n_in != N_IN || in_sizes[0] != M * D || out_size != M * D || ws_size < WS_END) {
            fprintf(stderr, "kernel_launch: unexpected problem: n_in %d in0 %d out %d ws %zu (need %zu)\n", n_in, n_in > 0 ? in_sizes[0] : -1, out_size, ws_size, (size_t)WS_END); grid = -1; return; }
        int dev = 0, cus = 0, per_cu = 0;
        if (hipGetDevice(&dev) != hipSuccess || hipDeviceGetAttribute(&cus, hipDeviceAttributeMultiprocessorCount, dev) != hipSuccess) { grid = -1; return; }
        if (hipFuncSetAttribute((const void*)fwd_kernel, hipFuncAttributeMaxDynamicSharedMemorySize, LDS_BYTES) != hipSuccess) { fprintf(stderr, "kernel_launch: hipFuncSetAttribute failed\n"); grid = -1; return; }
        if (hipOccupancyMaxActiveBlocksPerMultiprocessor(&per_cu, (const void*)fwd_kernel, NWAVES * 64, LDS_BYTES) != hipSuccess || per_cu < 1)
            fprintf(stderr, "kernel_launch: note: occupancy query reports %d workgroups per CU\n", per_cu);
        (void)hipGetLastError();
        grid = cus;
        if (grid != 256) fprintf(stderr, "kernel_launch: note: %d CUs (built for 256)\n", grid);
    }
    if (grid < 0) return;
    if (hipMemsetAsync((char*)d_ws + WS_CTL, 0, CTL_ZERO_BYTES, stream) != hipSuccess) { fprintf(stderr, "kernel_launch: memset failed\n"); return; }
    Args a{};
    for (int i = 0; i < N_IN; ++i) a.in[i] = (const float*)d_in[i];
    a.out = (float*)d_out; a.ws = (unsigned char*)d_ws;
#if MK_PER_PHASE
    for (int pid = 0; pid < NPH; ++pid) {
        if (!phase_exists(pid)) continue;
        a.ph_lo = pid; a.ph_hi = pid + 1;
        hipLaunchKernelGGL(fwd_kernel, dim3(grid), dim3(NWAVES * 64), LDS_BYTES, stream, a);
    }
#else
    a.ph_lo = 0; a.ph_hi = NPH;
    hipLaunchKernelGGL(fwd_kernel, dim3(grid), dim3(NWAVES * 64), LDS_BYTES, stream, a);
#endif
    const hipError_t le = hipPeekAtLastError();
    if (le != hipSuccess) fprintf(stderr, "kernel_launch: launch failed: %s\n", hipGetErrorName(le));
}
```
